# Optimizing an MI355X kernel written in HIP

```python
import jax, jax.numpy as jnp
from jax import lax
import numpy as np

D_MODEL = 1024
BATCH = 8
SEQ = 2048
DEPTH = 2

CHUNK = 64
N_MEM = 256
HEAD_DIM = 64
A_HEADS = 6
A_WIDTH = A_HEADS * HEAD_DIM
A_DECAY_LORA = 32
A_ICLR_LORA = 32
A_VRES_LORA = 32
A_GATE_LORA = 64
A_GN_EPS = 64e-5
A_PROJ = 3 * A_WIDTH + A_DECAY_LORA + A_ICLR_LORA + A_GATE_LORA
B_HEADS = 6
B_WIDTH = B_HEADS * HEAD_DIM
B_PREV_CHUNKS = 8
B_BAND = (B_PREV_CHUNKS + 1) * CHUNK
REL_MAX = 256
N_REL = CHUNK - 1 + REL_MAX + 1
C_GROUPS = 4
C_GROUP_DIM = 64
C_WIDTH = C_GROUPS * C_GROUP_DIM
POOL_WINDOWS = (2, 4, 8, 16)
MIX_WIDTH = A_WIDTH + B_WIDTH + C_WIDTH
IN_PROJ = A_PROJ + 3 * B_WIDTH + C_WIDTH
X_HEADS = 4
X_HEAD_DIM = D_MODEL // X_HEADS
D_FF = 2816
RMS_EPS = 1e-6
NEG_INF = -1e30

kernel_name = "hybrid_rwkv7_chunkattn_pool_macaron"


def rms_norm(x, g):
    xf = x.astype(jnp.float32)
    y = xf * lax.rsqrt(jnp.mean(xf * xf, axis=-1, keepdims=True) + RMS_EPS)
    return (y * g.astype(jnp.float32)).astype(x.dtype)


def swiglu(x, w_in, w_out):
    gate, up = jnp.split(x @ w_in, 2, axis=-1)
    return (jax.nn.silu(gate) * up) @ w_out


def token_shift(p):
    return jnp.pad(p, ((0, 0), (1, 0), (0, 0)))[:, :-1]


def rwkv7_mixer(p, v_first, mu, w0, w_up, a0, a_up, g_up, k_k, k_a, r_k, gn_g, gn_b, vres):
    B_, T, _ = p.shape
    f32 = jnp.float32
    p = p + mu * (token_shift(p) - p)
    r, k, v, wd, ad, gd = jnp.split(
        p, [A_WIDTH, 2 * A_WIDTH, 3 * A_WIDTH, 3 * A_WIDTH + A_DECAY_LORA,
            3 * A_WIDTH + A_DECAY_LORA + A_ICLR_LORA], axis=-1)
    w = -jax.nn.softplus(-(w0 + jnp.tanh(wd) @ w_up)) - 0.5
    decay = jnp.exp(-jnp.exp(w.astype(f32)))
    a = jax.nn.sigmoid(a0 + ad @ a_up)
    g = jax.nn.sigmoid(gd) @ g_up
    if vres is None:
        v_first = v
    else:
        v0, v_down, v_up = vres
        v = v + (v_first - v) * jax.nn.sigmoid(v0 + (v @ v_down) @ v_up)
    kk = (k * k_k).reshape(B_, T, A_HEADS, HEAD_DIM).astype(f32)
    kk = kk / jnp.maximum(jnp.sqrt(jnp.sum(kk * kk, axis=-1, keepdims=True)), 1e-12)
    k = k * (1.0 + (a - 1.0) * k_a)
    hs = lambda t: t.reshape(B_, T, A_HEADS, HEAD_DIM).astype(f32)
    r_h, k_h, v_h, w_h, a_h = hs(r), hs(k), hs(v), hs(decay), hs(a)

    def step(S, inp):
        r_t, k_t, v_t, w_t, kk_t, a_t = inp
        sa = jnp.einsum('bhvk,bhk->bhv', S, -kk_t)
        S = (S * w_t[:, :, None, :] + sa[..., None] * (kk_t * a_t)[:, :, None, :]
             + v_t[..., None] * k_t[:, :, None, :])
        return S, jnp.einsum('bhvk,bhk->bhv', S, r_t)

    xs = tuple(jnp.moveaxis(t, 1, 0) for t in (r_h, k_h, v_h, w_h, kk, a_h))
    S0 = jnp.zeros((B_, A_HEADS, HEAD_DIM, HEAD_DIM), f32)
    _, y = lax.scan(step, S0, xs)
    y = jnp.moveaxis(y, 0, 1)
    mean = jnp.mean(y, axis=-1, keepdims=True)
    var = jnp.mean(jnp.square(y - mean), axis=-1, keepdims=True)
    y = ((y - mean) * lax.rsqrt(var + A_GN_EPS)).reshape(B_, T, A_WIDTH) * gn_g + gn_b
    bonus = (jnp.sum(r_h * k_h * r_k, axis=-1, keepdims=True) * v_h).reshape(B_, T, A_WIDTH)
    return ((y + bonus) * g).astype(p.dtype), v_first


def chunk_attention(q, k, v, q_gain, k_gain, rel_bias):
    B_, T, _ = q.shape
    NC = T // CHUNK
    q = rms_norm(q.reshape(B_, T, B_HEADS, HEAD_DIM), q_gain)
    k = rms_norm(k.reshape(B_, T, B_HEADS, HEAD_DIM), k_gain)
    v = v.reshape(B_, T, B_HEADS, HEAD_DIM)
    qc = q.reshape(B_, NC, CHUNK, B_HEADS, HEAD_DIM)
    pad = ((0, 0), (B_PREV_CHUNKS * CHUNK, 0), (0, 0), (0, 0))
    kc = jnp.pad(k, pad).reshape(B_, NC + B_PREV_CHUNKS, CHUNK, B_HEADS, HEAD_DIM)
    vc = jnp.pad(v, pad).reshape(B_, NC + B_PREV_CHUNKS, CHUNK, B_HEADS, HEAD_DIM)
    band_idx = np.arange(NC)[:, None] + np.arange(B_PREV_CHUNKS + 1)[None, :]
    kb = kc[:, band_idx].reshape(B_, NC, B_BAND, B_HEADS, HEAD_DIM)
    vb = vc[:, band_idx].reshape(B_, NC, B_BAND, B_HEADS, HEAD_DIM)
    s = jnp.einsum('bnihd,bnjhd->bhnij', qc, kb).astype(jnp.float32) * (HEAD_DIM ** -0.5)
    dist = B_PREV_CHUNKS * CHUNK + np.arange(CHUNK)[:, None] - np.arange(B_BAND)[None, :]
    rel_idx = np.clip(dist, -(CHUNK - 1), REL_MAX) + (CHUNK - 1)
    bias = rel_bias.astype(jnp.float32)[:, rel_idx]
    valid = (np.arange(NC)[:, None] + (np.arange(B_BAND) // CHUNK)[None, :]) >= B_PREV_CHUNKS
    s = jnp.where(valid[None, None, :, None, :], s + bias[:, None], NEG_INF)
    prob = jax.nn.softmax(s, axis=-1).astype(v.dtype)
    o = jnp.einsum('bhnij,bnjhd->bnihd', prob, vb)
    return o.reshape(B_, T, B_WIDTH)


def multiscale_pool(u, pool_w, pool_scale):
    B_, T, _ = u.shape
    uf = u.astype(jnp.float32).reshape(B_, T, C_GROUPS, C_GROUP_DIM)
    cs = jnp.cumsum(uf, axis=1)
    t1 = jnp.arange(1, T + 1, dtype=jnp.float32)
    outs = []
    for gi, win in enumerate(POOL_WINDOWS):
        c = cs[:, :, gi]
        prev = jnp.pad(c, ((0, 0), (win, 0), (0, 0)))[:, :T]
        cnt = jnp.minimum(t1, float(win))[None, :, None]
        outs.append((c - prev) / cnt - uf[:, :, gi])
    pooled = jnp.stack(outs, axis=2)
    y = jnp.einsum('btgc,gcd->btgd', pooled, pool_w.astype(jnp.float32)).reshape(B_, T, C_WIDTH)
    return (y * pool_scale).astype(u.dtype)


def memory_cross_attention(h, mem_n, wq, wkv, wo, q_gain, k_gain):
    B_, T, _ = h.shape
    M = mem_n.shape[1]
    q = rms_norm((h @ wq).reshape(B_, T, X_HEADS, X_HEAD_DIM), q_gain)
    k, v = jnp.split(mem_n @ wkv, 2, axis=-1)
    k = rms_norm(k.reshape(B_, M, X_HEADS, X_HEAD_DIM), k_gain)
    v = v.reshape(B_, M, X_HEADS, X_HEAD_DIM)
    s = jnp.einsum('bthd,bmhd->bhtm', q, k).astype(jnp.float32) * (X_HEAD_DIM ** -0.5)
    prob = jax.nn.softmax(s, axis=-1).astype(v.dtype)
    o = jnp.einsum('bhtm,bmhd->bthd', prob, v).reshape(B_, T, D_MODEL)
    return o @ wo


def setup_inputs(seed: int = 0) -> dict:
    key = jax.random.key(seed)
    ks = iter(jax.random.split(key, 64))
    f32 = jnp.float32
    L, D = DEPTH, D_MODEL

    def nrm(shape, scale):
        return scale * jax.random.normal(next(ks), shape, f32)

    def gain(shape, base=1.0, noise=0.1):
        return base + noise * jax.random.normal(next(ks), shape, f32)

    return {
        "x": nrm((BATCH, SEQ, D), 1.0),
        "mem": nrm((BATCH, N_MEM, D), 1.0),
        "norm_ffn1": gain((L, D)),
        "ffn1_wi": nrm((L, D, 2 * D_FF), D ** -0.5),
        "ffn1_wo": nrm((L, D_FF, D), D_FF ** -0.5),
        "norm_mix": gain((L, D)),
        "w_in": nrm((L, D, IN_PROJ), D ** -0.5),
        "w_out": nrm((L, MIX_WIDTH, D), MIX_WIDTH ** -0.5),
        "a_mu": jax.random.uniform(next(ks), (L, A_PROJ), f32),
        "a_w0": nrm((L, A_WIDTH), 0.5),
        "a_w_up": nrm((L, A_DECAY_LORA, A_WIDTH), 0.5 * A_DECAY_LORA ** -0.5),
        "a_a0": nrm((L, A_WIDTH), 0.5),
        "a_a_up": nrm((L, A_ICLR_LORA, A_WIDTH), 0.5 * A_ICLR_LORA ** -0.5),
        "a_g_up": nrm((L, A_GATE_LORA, A_WIDTH), A_GATE_LORA ** -0.5),
        "a_k_k": gain((L, A_WIDTH), 0.85, 0.05),
        "a_k_a": gain((L, A_WIDTH), 1.0, 0.05),
        "a_r_k": nrm((L, A_HEADS, HEAD_DIM), 0.1),
        "a_gn_g": gain((L, A_WIDTH)),
        "a_gn_b": nrm((L, A_WIDTH), 0.02),
        "a_v0": nrm((L - 1, A_WIDTH), 0.5),
        "a_v_down": nrm((L - 1, A_WIDTH, A_VRES_LORA), A_WIDTH ** -0.5),
        "a_v_up": nrm((L - 1, A_VRES_LORA, A_WIDTH), 0.5 * A_VRES_LORA ** -0.5),
        "b_q_gain": gain((L, HEAD_DIM)),
        "b_k_gain": gain((L, HEAD_DIM)),
        "b_rel_bias": nrm((L, B_HEADS, N_REL), 0.5),
        "c_pool_w": nrm((L, C_GROUPS, C_GROUP_DIM, C_GROUP_DIM), C_GROUP_DIM ** -0.5),
        "c_pool_scale": gain((L, C_WIDTH)),
        "norm_cross": gain((L, D)),
        "norm_mem": gain((L, D)),
        "x_wq": nrm((L, D, D), D ** -0.5),
        "x_wkv": nrm((L, D, 2 * D), D ** -0.5),
        "x_wo": nrm((L, D, D), D ** -0.5),
        "x_q_gain": gain((L, X_HEAD_DIM)),
        "x_k_gain": gain((L, X_HEAD_DIM)),
        "norm_ffn2": gain((L, D)),
        "ffn2_wi": nrm((L, D, 2 * D_FF), D ** -0.5),
        "ffn2_wo": nrm((L, D_FF, D), D_FF ** -0.5),
    }


def reference(x, mem, norm_ffn1, ffn1_wi, ffn1_wo, norm_mix, w_in, w_out,
              a_mu, a_w0, a_w_up, a_a0, a_a_up, a_g_up, a_k_k, a_k_a, a_r_k, a_gn_g, a_gn_b,
              a_v0, a_v_down, a_v_up, b_q_gain, b_k_gain, b_rel_bias, c_pool_w, c_pool_scale,
              norm_cross, norm_mem, x_wq, x_wkv, x_wo, x_q_gain, x_k_gain,
              norm_ffn2, ffn2_wi, ffn2_wo):
    split_pts = [A_PROJ, A_PROJ + B_WIDTH, A_PROJ + 2 * B_WIDTH, A_PROJ + 3 * B_WIDTH]
    v_first = None
    for l in range(DEPTH):
        x = x + 0.5 * swiglu(rms_norm(x, norm_ffn1[l]), ffn1_wi[l], ffn1_wo[l])
        h = rms_norm(x, norm_mix[l])
        p = h @ w_in[l]
        p_a, p_q, p_k, p_v, p_c = jnp.split(p, split_pts, axis=-1)
        vres = None if l == 0 else (a_v0[l - 1], a_v_down[l - 1], a_v_up[l - 1])
        y_a, v_first = rwkv7_mixer(p_a, v_first, a_mu[l], a_w0[l], a_w_up[l], a_a0[l], a_a_up[l],
                                   a_g_up[l], a_k_k[l], a_k_a[l], a_r_k[l], a_gn_g[l], a_gn_b[l], vres)
        y_b = chunk_attention(p_q, p_k, p_v, b_q_gain[l], b_k_gain[l], b_rel_bias[l])
        y_c = multiscale_pool(p_c, c_pool_w[l], c_pool_scale[l])
        x = x + jnp.concatenate([y_a, y_b, y_c], axis=-1) @ w_out[l]
        x = x + memory_cross_attention(rms_norm(x, norm_cross[l]), rms_norm(mem, norm_mem[l]),
                                       x_wq[l], x_wkv[l], x_wo[l], x_q_gain[l], x_k_gain[l])
        x = x + 0.5 * swiglu(rms_norm(x, norm_ffn2[l]), ffn2_wi[l], ffn2_wo[l])
    return x
```

```cpp
#include <hip/hip_runtime.h>
#include <hip/hip_cooperative_groups.h>
#include <cstdio>
#include <cstdint>
namespace cg = cooperative_groups;

#ifndef REPK
#define REPK -1
#endif
#ifndef MK_LAUNCHES
#define MK_LAUNCHES 1
#endif

namespace pg8 {
#define PG8_LAS __attribute__((address_space(3)))
typedef unsigned short bf16_t;
typedef short bf16x8 __attribute__((ext_vector_type(8)));
typedef float f32x4 __attribute__((ext_vector_type(4)));
typedef unsigned u32x4 __attribute__((ext_vector_type(4)));
constexpr int BM = 256, BK = 64, HALF = 128, HTB = HALF * BK * 2  , STAGE_BYTES = 8 * HTB, NXCD = 8, WGM = 8;

__host__ __device__ __forceinline__ int lds_byte(int r, int c) { const int st = (r >> 4) * 2 + (c >> 5), rr = r & 15, cc = c & 31, ob = rr * 64 + cc * 2; return st * 1024 + (ob ^ (((ob >> 9) & 1) << 5)); }
__host__ __device__ __forceinline__ void stage_rc(int b, int& R, int& C) { const int st = b / 1024, sb = b % 1024, swz = sb ^ (((sb >> 9) & 1) << 5); R = (st >> 1) * 16 + swz / 64; C = (st & 1) * 32 + (swz % 64) / 2; }
__host__ __device__ __forceinline__ int perm32(int rho) { const int n = rho >> 4, i = rho & 15; return 8 * (i >> 2) + 4 * n + (i & 3); }

struct Unit { int pm, pn; };
struct Gemm { const bf16_t* A; const bf16_t* Bt; int M, N, K; };

struct StaticOrder {
    int nM, nN, nwg, G, c;
    __host__ __device__ void init(int M, int N, int G_, int c_) { nM = M / BM; nN = N / BM; nwg = nM * nN; G = G_; c = c_; }
    __host__ __device__ bool next(int i, Unit& u) const {
        const long L = (long)i * G + c; if (L >= nwg) return false;
        int wgid = (int)L; { const int q = nwg / NXCD, r = nwg % NXCD, xcd = wgid % NXCD, off = wgid / NXCD; wgid = (xcd < r ? xcd * (q + 1) : r * (q + 1) + (xcd - r) * q) + off; }
        const int nig = WGM * nN, gid = wgid / nig, fm = gid * WGM, gsz = (nM - fm) < WGM ? (nM - fm) : WGM;
        u.pm = fm + ((wgid % nig) % gsz); u.pn = (wgid % nig) / gsz; return true;
    }
    __device__ __forceinline__ void a_ready(const Unit&) const {}
    __device__ __forceinline__ void done(const Unit&) const {}
};

template <class Epi, class Sched, bool ALIGN_EPI = false, bool SP2 = false>
__device__ __forceinline__ void gemm_phase(PG8_LAS unsigned char* lds, const Gemm g, const Sched& S, const Epi& E, const int tid) {
    const int wid = __builtin_amdgcn_readfirstlane(tid >> 6), lane = tid & 63, wr = wid >> 2, wc = wid & 3, fr = lane & 15, fq = lane >> 4;
    const int K = g.K, nt = K / BK;
    unsigned voffA[2], voffB[2];
#pragma unroll
    for (int i = 0; i < 2; ++i) { int R, C; stage_rc(tid * 16 + i * 8192, R, C); const int Rb = Epi::PERM ? ((R & ~31) + perm32(R & 31)) : R;
        voffA[i] = (unsigned)(R * K + C) * 2u; voffB[i] = (unsigned)(Rb * K + C) * 2u; }
    const size_t kstep = (size_t)(BK * 2);
    const size_t hstep = (size_t)HALF * K * 2;
    const size_t tstep = 2 * hstep;
    const unsigned ldsw = (unsigned)wid * 1024u;
    const int aoff = lds_byte(wr * 64 + fr, fq * 8), boff = lds_byte(wc * 32 + fr, fq * 8);
#define PG8_SA(b, h) (((b) * 2 + (h)) * HTB)
#define PG8_SB(b, h) ((4 + (b) * 2 + (h)) * HTB)
#define PG8_STAGE(bufoff, gbase, voff) do { _Pragma("unroll") for (int _i = 0; _i < 2; ++_i) \
        __builtin_amdgcn_global_load_lds((const unsigned*)((const char*)(gbase) + (voff)[_i]), (PG8_LAS unsigned*)(lds + (bufoff) + ldsw + _i * 8192), 16, 0, 0); } while (0)
#define PG8_LDA(dst, b, h) do { _Pragma("unroll") for (int m = 0; m < 4; ++m) _Pragma("unroll") for (int k = 0; k < 2; ++k) dst[m][k] = *(const PG8_LAS bf16x8*)(lds + PG8_SA(b, h) + aoff + m * 2048 + k * 1024); } while (0)
#define PG8_LDB(dst, b, h) do { _Pragma("unroll") for (int n = 0; n < 2; ++n) _Pragma("unroll") for (int k = 0; k < 2; ++k) dst[n][k] = *(const PG8_LAS bf16x8*)(lds + PG8_SB(b, h) + boff + n * 2048 + k * 1024); } while (0)
#define PG8_MMA(ai, bj, At, Bt) do { __builtin_amdgcn_s_setprio(1); _Pragma("unroll") for (int m = 0; m < 4; ++m) _Pragma("unroll") for (int n = 0; n < 2; ++n) _Pragma("unroll") for (int k = 0; k < 2; ++k) \
        acc[ai][bj][m][n] = __builtin_amdgcn_mfma_f32_16x16x32_bf16(Bt[n][k], At[m][k], acc[ai][bj][m][n], 0, 0, 0); __builtin_amdgcn_s_setprio(0); } while (0)
#define PG8_WAIT_V(n) asm volatile("s_waitcnt vmcnt(" #n ")" ::: "memory")
#define PG8_WAIT_L(n) asm volatile("s_waitcnt lgkmcnt(" #n ")" ::: "memory")
#define PG8_BAR __builtin_amdgcn_s_barrier()
#define PG8_SCHED __builtin_amdgcn_sched_barrier(0)
    Unit cur, nxt; int ui = 0;
    if (!S.next(0, cur)) return;
    f32x4 acc[2][2][4][2];
#pragma unroll
    for (int a = 0; a < 2; ++a)
#pragma unroll
        for (int b = 0; b < 2; ++b)
#pragma unroll
            for (int m = 0; m < 4; ++m)
#pragma unroll
                for (int n = 0; n < 2; ++n) acc[a][b][m][n] = (f32x4){0.f, 0.f, 0.f, 0.f};
    bf16x8 At[4][2], B0[2][2], B1[2][2];
    const char* cA = (const char*)g.A + (size_t)cur.pm * tstep; const char* cB = (const char*)g.Bt + (size_t)cur.pn * tstep;
    S.a_ready(cur);
    if constexpr (SP2) {
        PG8_STAGE(PG8_SB(0, 0), cB, voffB); PG8_STAGE(PG8_SB(0, 1), cB + hstep, voffB); PG8_STAGE(PG8_SA(0, 0), cA, voffA); PG8_STAGE(PG8_SA(0, 1), cA + hstep, voffA);
        if (wr == 1) PG8_BAR;
        PG8_WAIT_V(2); PG8_BAR;
        PG8_STAGE(PG8_SB(1, 0), cB + kstep, voffB); PG8_STAGE(PG8_SA(1, 0), cA + kstep, voffA); PG8_STAGE(PG8_SB(1, 1), cB + hstep + kstep, voffB);
        PG8_WAIT_V(6); PG8_BAR;
    } else {
        PG8_STAGE(PG8_SB(0, 0), cB, voffB); PG8_STAGE(PG8_SA(0, 0), cA, voffA); PG8_STAGE(PG8_SB(0, 1), cB + hstep, voffB); PG8_STAGE(PG8_SA(0, 1), cA + hstep, voffA);
        if (wr == 1) PG8_BAR;
        PG8_WAIT_V(4); PG8_BAR;
        PG8_STAGE(PG8_SB(1, 0), cB + kstep, voffB); PG8_STAGE(PG8_SA(1, 0), cA + kstep, voffA); PG8_STAGE(PG8_SB(1, 1), cB + hstep + kstep, voffB);
        PG8_WAIT_V(6); PG8_BAR;
    }
    for (;;) {
        const bool has_next = S.next(ui + 1, nxt);
        const char* nA = has_next ? (const char*)g.A + (size_t)nxt.pm * tstep : cA; const char* nB = has_next ? (const char*)g.Bt + (size_t)nxt.pn * tstep : cB;
        for (int t = 0; t < nt; t += 2) {
            const bool last = (t == nt - 2);
            const char* a1 = cA + (size_t)(t + 1) * kstep;
            const char* a2 = last ? nA : cA + (size_t)(t + 2) * kstep; const char* b2 = last ? nB : cB + (size_t)(t + 2) * kstep;
            const char* a3 = a2 + kstep; const char* b3 = b2 + kstep;
            if (last && has_next) S.a_ready(nxt);
            if constexpr (SP2) {
            PG8_LDB(B0, 0, 0); PG8_LDB(B1, 0, 1); PG8_SCHED; PG8_LDA(At, 0, 0); PG8_STAGE(PG8_SA(1, 1), a1 + hstep, voffA);
            PG8_WAIT_V(8); PG8_WAIT_L(0); PG8_BAR; PG8_MMA(0, 0, At, B0); PG8_MMA(0, 1, At, B1); PG8_BAR; PG8_SCHED;
            PG8_LDA(At, 0, 1); PG8_STAGE(PG8_SB(0, 0), b2, voffB); PG8_STAGE(PG8_SB(0, 1), b2 + hstep, voffB); PG8_STAGE(PG8_SA(0, 0), a2, voffA);
            PG8_WAIT_V(8); PG8_WAIT_L(0); PG8_BAR; PG8_MMA(1, 0, At, B0); PG8_MMA(1, 1, At, B1); PG8_BAR; PG8_SCHED;
            PG8_LDB(B0, 1, 0); PG8_LDB(B1, 1, 1); PG8_SCHED; PG8_LDA(At, 1, 0); PG8_STAGE(PG8_SA(0, 1), a2 + hstep, voffA);
            PG8_WAIT_V(8); PG8_WAIT_L(0); PG8_BAR; PG8_MMA(0, 0, At, B0); PG8_MMA(0, 1, At, B1); PG8_BAR; PG8_SCHED;
            PG8_LDA(At, 1, 1); PG8_STAGE(PG8_SB(1, 0), b3, voffB); PG8_STAGE(PG8_SB(1, 1), b3 + hstep, voffB); PG8_STAGE(PG8_SA(1, 0), a3, voffA);
            PG8_WAIT_V(8); PG8_WAIT_L(0); PG8_BAR; PG8_MMA(1, 0, At, B0); PG8_MMA(1, 1, At, B1); PG8_BAR; PG8_SCHED;
            } else {
            PG8_LDB(B0, 0, 0); PG8_SCHED; PG8_LDA(At, 0, 0); PG8_STAGE(PG8_SA(1, 1), a1 + hstep, voffA);
            PG8_WAIT_L(8); PG8_BAR; PG8_WAIT_L(0); PG8_MMA(0, 0, At, B0); PG8_BAR; PG8_SCHED;
            PG8_LDB(B1, 0, 1); PG8_STAGE(PG8_SB(0, 0), b2, voffB);
            PG8_BAR; PG8_WAIT_L(0); PG8_MMA(0, 1, At, B1); PG8_BAR;
            PG8_LDA(At, 0, 1); PG8_STAGE(PG8_SA(0, 0), a2, voffA);
            PG8_BAR; PG8_WAIT_L(0); PG8_MMA(1, 0, At, B0); PG8_BAR; PG8_SCHED;
            PG8_STAGE(PG8_SB(0, 1), b2 + hstep, voffB);
            PG8_WAIT_V(6); PG8_BAR; PG8_MMA(1, 1, At, B1); PG8_BAR;
            PG8_LDB(B0, 1, 0); PG8_SCHED; PG8_LDA(At, 1, 0); PG8_STAGE(PG8_SA(0, 1), a2 + hstep, voffA);
            PG8_WAIT_L(8); PG8_BAR; PG8_WAIT_L(0); PG8_MMA(0, 0, At, B0); PG8_BAR; PG8_SCHED;
            PG8_LDB(B1, 1, 1); PG8_STAGE(PG8_SB(1, 0), b3, voffB);
            PG8_BAR; PG8_WAIT_L(0); PG8_MMA(0, 1, At, B1); PG8_BAR;
            PG8_LDA(At, 1, 1); PG8_STAGE(PG8_SA(1, 0), a3, voffA);
            PG8_BAR; PG8_WAIT_L(0); PG8_MMA(1, 0, At, B0); PG8_BAR; PG8_SCHED;
            PG8_STAGE(PG8_SB(1, 1), b3 + hstep, voffB);
            PG8_WAIT_V(6); PG8_BAR; PG8_MMA(1, 1, At, B1); PG8_BAR;
            }
        }
        if constexpr (ALIGN_EPI) { if (wr == 0) PG8_BAR; }
        if constexpr (!Epi::AFTER_DRAIN) { E(acc, cur, wr, wc, fr, fq); S.done(cur); }
        if (!has_next) break;
#pragma unroll
        for (int a = 0; a < 2; ++a)
#pragma unroll
            for (int b = 0; b < 2; ++b)
#pragma unroll
                for (int m = 0; m < 4; ++m)
#pragma unroll
                    for (int n = 0; n < 2; ++n) acc[a][b][m][n] = (f32x4){0.f, 0.f, 0.f, 0.f};
        cur = nxt; cA = nA; cB = nB; ++ui;
        if constexpr (ALIGN_EPI) { if (wr == 1) PG8_BAR; }
    }
    PG8_WAIT_V(0);
    if constexpr (!ALIGN_EPI) { if (wr == 0) PG8_BAR; }
    PG8_BAR;
    if constexpr (Epi::AFTER_DRAIN) { E.fused(acc, cur, wr, wc, fr, fq, lds, wid, lane); S.done(cur); }
#undef PG8_SA
#undef PG8_SB
#undef PG8_STAGE
#undef PG8_LDA
#undef PG8_LDB
#undef PG8_MMA
#undef PG8_WAIT_V
#undef PG8_WAIT_L
#undef PG8_BAR
#undef PG8_SCHED
}
}

#define LAS __attribute__((address_space(3)))
typedef unsigned short bf16_t;
typedef short bf16x8 __attribute__((ext_vector_type(8)));
typedef short s16x4 __attribute__((ext_vector_type(4)));
typedef float f32x4 __attribute__((ext_vector_type(4)));
typedef float f32x2 __attribute__((ext_vector_type(2)));
typedef float f32x16 __attribute__((ext_vector_type(16)));
typedef unsigned u32x4 __attribute__((ext_vector_type(4)));
typedef unsigned u32x2 __attribute__((ext_vector_type(2)));
typedef _Float16 h4_t __attribute__((ext_vector_type(4)));
typedef _Float16 h8_t __attribute__((ext_vector_type(8)));
typedef __bf16 bfv2_t __attribute__((ext_vector_type(2)));
#define DI __device__ __forceinline__

DI unsigned pkbf(float a, float b) { bfv2_t v = __builtin_convertvector((f32x2){a, b}, bfv2_t); return __builtin_bit_cast(unsigned, v); }
DI float bf2f(unsigned short u) { return __uint_as_float(((unsigned)u) << 16); }
DI float bflo(unsigned u) { return __uint_as_float(u << 16); }
DI float bfhi(unsigned u) { return __uint_as_float(u & 0xffff0000u); }
DI float wave_sum(float v) {
#pragma unroll
  for (int o = 1; o < 64; o <<= 1) v += __shfl_xor(v, o);
  return v;
}
DI float vfma(float a, float b, float c) { float d; asm("v_fma_f32 %0, %1, %2, %3" : "=v"(d) : "v"(a), "v"(b), "v"(c)); return d; }
DI float sigmoidf_(float x) { return 1.0f / (1.0f + __expf(-x)); }
#define LDS_WAIT() asm volatile("s_waitcnt lgkmcnt(0)" ::: "memory")
template <int CTRL> DI float dpp_addx(float x) { return x + __builtin_bit_cast(float, __builtin_amdgcn_update_dpp(0, __builtin_bit_cast(int, x), CTRL, 0xf, 0xf, true)); }
DI float allreduce16(float x) { x = dpp_addx<0xB1>(x); x = dpp_addx<0x4E>(x); x = dpp_addx<0x141>(x); x = dpp_addx<0x140>(x); return x; }
DI float rdlane(float x, int l) { return __builtin_bit_cast(float, __builtin_amdgcn_readlane(__builtin_bit_cast(int, x), l)); }
DI float wave_sum_dpp(float x) { x = allreduce16(x); return (rdlane(x, 0) + rdlane(x, 16)) + (rdlane(x, 32) + rdlane(x, 48)); }


constexpr int MTOK = 16384, DM = 1024, TSEQ = 2048, NB = 8, DFF = 2816, PW = 2816  , NMEM = 256;
constexpr int AW = 384, APROJ = 1280;
constexpr int PQ = 1280, PK = 1664, PV = 2048, PC = 2432;
constexpr int THALF = 1024;
constexpr float RMS_EPS = 1e-6f;

constexpr size_t SZ_WI = (size_t)5632 * 1024 * 2, SZ_WO = (size_t)1024 * 2816 * 2, SZ_WIN = (size_t)2816 * 1024 * 2, SZ_WKV = (size_t)2048 * 1024 * 2, SZ_SQ = (size_t)1024 * 1024 * 2;
constexpr size_t W_WI1 = 0, W_WO1 = W_WI1 + SZ_WI, W_WIN = W_WO1 + SZ_WO, W_WKV = W_WIN + SZ_WIN, W_WOUT = W_WKV + SZ_WKV, W_WQ = W_WOUT + SZ_SQ, W_WOX = W_WQ + SZ_SQ,
                 W_WI2 = W_WOX + SZ_SQ, W_WO2 = W_WI2 + SZ_WI, W_END = W_WO2 + SZ_WO;
constexpr size_t WS_W = 0;
constexpr size_t WS_XB = WS_W + W_END;
constexpr size_t WS_MEMB = WS_XB + (size_t)MTOK * DM * 2;
constexpr size_t WS_U = WS_MEMB + (size_t)2048 * DM * 2;
constexpr size_t WS_R2 = WS_U + (size_t)MTOK * PW * 2;
constexpr size_t WS_VF = WS_R2 + (size_t)48 * THALF * 384 * 2;
constexpr size_t WS_KNC = WS_VF + (size_t)MTOK * AW * 2;
constexpr size_t WS_VTC = WS_KNC + (size_t)2048 * 1024 * 2;
constexpr size_t WS_KVC = WS_VTC + (size_t)2048 * 1024 * 2;
constexpr size_t WS_VTB = WS_KVC + (size_t)2048 * 2048 * 2;
constexpr size_t WS_SS = WS_VTB + (size_t)MTOK * AW * 2;
constexpr size_t WS_RKB = WS_SS + (size_t)MTOK * 16 * 4;
constexpr size_t WS_RSM = WS_RKB + (size_t)48 * 2048 * 4;
constexpr size_t WS_ST = WS_RSM + 2048 * 4;
constexpr size_t WS_BAR = WS_ST + (size_t)48 * 4096 * 4;
constexpr size_t WS_S6X = WS_BAR + 16384;
constexpr size_t S6_BH_BYTES = (size_t)TSEQ * 768;
constexpr size_t WS_END = WS_S6X + 8 * S6_BH_BYTES;
constexpr size_t WS_S6 = WS_XB;
constexpr size_t WS_Y = WS_R2;
constexpr size_t WS_YH = WS_W + W_WI1;
constexpr size_t WS_BON = WS_YH + (size_t)MTOK * AW * 2;
static_assert((size_t)48 * THALF * 384 * 2 == (size_t)(MTOK + 2048) * DM * 2, "S6 half must fit [xb | memb] exactly");
static_assert(2 * (size_t)MTOK * AW * 2 <= W_WOUT, "y + bonus must fit the dead weight prefix");

struct Params { const float* in[37]; float* out; unsigned char* ws; int ph_lo, ph_hi; };
typedef const Params __attribute__((address_space(4)))* KP;
DI unsigned char* s6_block(KP p, int bh) { return bh < 40 ? (unsigned char*)p->out + (size_t)bh * S6_BH_BYTES : p->ws + WS_S6X + (size_t)(bh - 40) * S6_BH_BYTES; }

DI float row_rstd16(const float* ss, int row) {
  const f32x4* p = (const f32x4*)(ss + (size_t)row * 16);
  f32x4 a = p[0], b = p[1], c = p[2], d = p[3];
  float s = ((a[0] + a[1]) + (a[2] + a[3])) + ((b[0] + b[1]) + (b[2] + b[3])) + ((c[0] + c[1]) + (c[2] + c[3])) + ((d[0] + d[1]) + (d[2] + d[3]));
  return __builtin_amdgcn_rsqf(s * (1.0f / 1024.0f) + RMS_EPS);
}
struct EpiScaleBf16 {
  static constexpr bool PERM = true, AFTER_DRAIN = false;
  bf16_t* O1; int ldc1; const float* ss; bf16_t* O2; int ldc2; const float* rs2;
  DI void operator()(const f32x4 (&acc)[2][2][4][2], const pg8::Unit& u, int wr, int wc, int fr, int fq) const {
    const bool kv = u.pm >= 64;
    bf16_t* base = kv ? O2 : O1; const int ldc = kv ? ldc2 : ldc1;
    const int row0 = (kv ? (u.pm - 64) : u.pm) * 256 + wr * 64 + fr, col0 = (kv ? (u.pn - 11) : u.pn) * 256 + wc * 32 + 8 * fq;
#pragma unroll
    for (int ai = 0; ai < 2; ++ai)
#pragma unroll
      for (int m = 0; m < 4; ++m) {
        const int row = row0 + ai * 128 + m * 16;
        const float rs = kv ? rs2[row] : row_rstd16(ss, row);
        bf16_t* rowp = base + (size_t)row * ldc + col0;
#pragma unroll
        for (int bj = 0; bj < 2; ++bj) {
          const f32x4 v0 = acc[ai][bj][m][0] * rs, v1 = acc[ai][bj][m][1] * rs;
          u32x4 w; w.x = pkbf(v0[0], v0[1]); w.y = pkbf(v0[2], v0[3]); w.z = pkbf(v1[0], v1[1]); w.w = pkbf(v1[2], v1[3]);
          *(u32x4*)(rowp + bj * 128) = w;
        }
      }
  }
};
struct EpiSwiGLU {
  static constexpr bool PERM = true, AFTER_DRAIN = false;
  bf16_t* O; const float* ss;
  DI void operator()(const f32x4 (&acc)[2][2][4][2], const pg8::Unit& u, int wr, int wc, int fr, int fq) const {
    const int row0 = u.pm * 256 + wr * 64 + fr, col0 = u.pn * 128 + wc * 32 + 8 * fq;
#pragma unroll
    for (int ai = 0; ai < 2; ++ai)
#pragma unroll
      for (int m = 0; m < 4; ++m) {
        const int row = row0 + ai * 128 + m * 16;
        const float rs = row_rstd16(ss, row);
        float o[8];
#pragma unroll
        for (int n = 0; n < 2; ++n)
#pragma unroll
          for (int j = 0; j < 4; ++j) { const float g = acc[ai][0][m][n][j] * rs, up = acc[ai][1][m][n][j] * rs; o[n * 4 + j] = g * up / (1.0f + __expf(-g)); }
        u32x4 w; w.x = pkbf(o[0], o[1]); w.y = pkbf(o[2], o[3]); w.z = pkbf(o[4], o[5]); w.w = pkbf(o[6], o[7]);
        *(u32x4*)(O + (size_t)row * DFF + col0) = w;
      }
  }
};
struct EpiResid {
  static constexpr bool PERM = true, AFTER_DRAIN = false;
  const float* Xin32; float* Xout32; bf16_t* XB; float* ss; float scale; int first, last;
  DI void operator()(const f32x4 (&acc)[2][2][4][2], const pg8::Unit& u, int wr, int wc, int fr, int fq) const {
    const int row0 = u.pm * 256 + wr * 64 + fr, col0 = u.pn * 256 + wc * 32 + 8 * fq;
#pragma unroll
    for (int ai = 0; ai < 2; ++ai)
#pragma unroll
      for (int m = 0; m < 4; ++m) {
        const int row = row0 + ai * 128 + m * 16; const size_t off = (size_t)row * DM + col0;
        float sq = 0.f;
#pragma unroll
        for (int bj = 0; bj < 2; ++bj) {
          const size_t o = off + bj * 128;
          f32x4 x0, x1;
          if (first) { x0 = *(const f32x4*)(Xin32 + o); x1 = *(const f32x4*)(Xin32 + o + 4); }
          else { const u32x4 ub = *(const u32x4*)(XB + o); x0[0] = bflo(ub.x); x0[1] = bfhi(ub.x); x0[2] = bflo(ub.y); x0[3] = bfhi(ub.y); x1[0] = bflo(ub.z); x1[1] = bfhi(ub.z); x1[2] = bflo(ub.w); x1[3] = bfhi(ub.w); }
          const f32x4 n0 = x0 + acc[ai][bj][m][0] * scale, n1 = x1 + acc[ai][bj][m][1] * scale;
          if (last) { *(f32x4*)(Xout32 + o) = n0; *(f32x4*)(Xout32 + o + 4) = n1; }
          else { u32x4 w; w.x = pkbf(n0[0], n0[1]); w.y = pkbf(n0[2], n0[3]); w.z = pkbf(n1[0], n1[1]); w.w = pkbf(n1[2], n1[3]); *(u32x4*)(XB + o) = w; }
          sq += ((n0[0] * n0[0] + n0[1] * n0[1]) + (n0[2] * n0[2] + n0[3] * n0[3])) + ((n1[0] * n1[0] + n1[1] * n1[1]) + (n1[2] * n1[2] + n1[3] * n1[3]));
        }
        sq += __shfl_xor(sq, 16); sq += __shfl_xor(sq, 32);
        if (fq == 0 && !last) ss[(size_t)row * 16 + u.pn * 4 + wc] = sq;
      }
  }
};
struct WinOrder {
  pg8::StaticOrder so; int G, c, nkv;
  DI void init(int N_, int G_, int c_, int with_kv) { so.init(MTOK, N_, G_, c_); G = G_; c = c_; nkv = with_kv ? 64 : 0; }
  DI bool next(int i, pg8::Unit& u) const {
    const long L = (long)i * G + c;
    if (L < so.nwg) return so.next(i, u);
    const int j = (int)(L - so.nwg); if (j >= nkv) return false;
    u.pm = 64 + (j >> 3); u.pn = 11 + (j & 7); return true;
  }
  DI void a_ready(const pg8::Unit&) const {}
  DI void done(const pg8::Unit&) const {}
};

struct ConvDesc { const float* W; const float* g; bf16_t* WT; int K, Nsrc, mode, nvalid, item, nblk; };
DI void conv_load(const ConvDesc& d, int lane, f32x4 (&v)[8], float (&gv)[8]) {
  const int kb = d.item / d.nblk, nb = d.item % d.nblk, k0 = 64 * kb, n0 = 32 * nb;
  int sc = n0;
  if (d.mode == 1) { const int pn = n0 >> 8, c = n0 & 255; sc = (c < 128) ? (128 * pn + c) : (2816 + 128 * pn + (c - 128)); }
  const bool valid = n0 < d.nvalid;
  const int kr = lane >> 3, n4 = (lane & 7) * 4;
#pragma unroll
  for (int i = 0; i < 8; ++i) {
    const int kk = 8 * i + kr;
    v[i] = valid ? *(const f32x4*)(d.W + (size_t)(k0 + kk) * d.Nsrc + sc + n4) : (f32x4){0.f, 0.f, 0.f, 0.f};
    gv[i] = d.g ? d.g[k0 + kk] : 1.0f;
  }
}
DI void conv_finish(const ConvDesc& d, const f32x4 (&v)[8], const float (&gv)[8], LAS float* scr, int lane) {
  const int kb = d.item / d.nblk, nb = d.item % d.nblk, k0 = 64 * kb, n0 = 32 * nb;
  const int kr = lane >> 3, n4 = (lane & 7) * 4;
#pragma unroll
  for (int i = 0; i < 8; ++i) {
    const int kk = 8 * i + kr; LAS float* dd = scr + kk * 33 + n4;
    dd[0] = v[i][0] * gv[i]; dd[1] = v[i][1] * gv[i]; dd[2] = v[i][2] * gv[i]; dd[3] = v[i][3] * gv[i];
  }
  LDS_WAIT();
  const int c = lane & 7;
#pragma unroll
  for (int j = 0; j < 4; ++j) {
    const int n = (lane >> 3) + 8 * j; const LAS float* s = scr + (8 * c) * 33 + n;
    u32x4 o; o.x = pkbf(s[0 * 33], s[1 * 33]); o.y = pkbf(s[2 * 33], s[3 * 33]); o.z = pkbf(s[4 * 33], s[5 * 33]); o.w = pkbf(s[6 * 33], s[7 * 33]);
    *(u32x4*)(d.WT + (size_t)(n0 + n) * d.K + k0 + 8 * c) = o;
  }
  LDS_WAIT();
}
DI ConvDesc conv_desc(KP p, int l, int it) {
  unsigned char* W = p->ws + WS_W;
  constexpr int I_WI = 16 * 176, I_WO = 44 * 32, I_WIN = 16 * 88, I_WKV = 16 * 64, I_SQ = 16 * 32;
  int r = it;
  if (r < I_WI) return ConvDesc{p->in[3] + (size_t)l * 1024 * 5632, p->in[2] + l * 1024, (bf16_t*)(W + W_WI1), 1024, 5632, 1, 5632, r, 176}; r -= I_WI;
  if (r < I_WO) return ConvDesc{p->in[4] + (size_t)l * 2816 * 1024, nullptr, (bf16_t*)(W + W_WO1), 2816, 1024, 0, 1024, r, 32}; r -= I_WO;
  if (r < I_WIN) return ConvDesc{p->in[6] + (size_t)l * 1024 * 2688, p->in[5] + l * 1024, (bf16_t*)(W + W_WIN), 1024, 2688, 0, 2688, r, 88}; r -= I_WIN;
  if (r < I_WKV) return ConvDesc{p->in[30] + (size_t)l * 1024 * 2048, p->in[28] + l * 1024, (bf16_t*)(W + W_WKV), 1024, 2048, 0, 2048, r, 64}; r -= I_WKV;
  if (r < I_SQ) return ConvDesc{p->in[7] + (size_t)l * 1024 * 1024, nullptr, (bf16_t*)(W + W_WOUT), 1024, 1024, 0, 1024, r, 32}; r -= I_SQ;
  if (r < I_SQ) return ConvDesc{p->in[29] + (size_t)l * 1024 * 1024, p->in[27] + l * 1024, (bf16_t*)(W + W_WQ), 1024, 1024, 0, 1024, r, 32}; r -= I_SQ;
  if (r < I_SQ) return ConvDesc{p->in[31] + (size_t)l * 1024 * 1024, nullptr, (bf16_t*)(W + W_WOX), 1024, 1024, 0, 1024, r, 32}; r -= I_SQ;
  if (r < I_WI) return ConvDesc{p->in[35] + (size_t)l * 1024 * 5632, p->in[34] + l * 1024, (bf16_t*)(W + W_WI2), 1024, 5632, 1, 5632, r, 176}; r -= I_WI;
  return ConvDesc{p->in[36] + (size_t)l * 2816 * 1024, nullptr, (bf16_t*)(W + W_WO2), 2816, 1024, 0, 1024, r, 32};
}
DI void phase_conv(KP p, int l, LAS unsigned char* lds, int gw, int NGW, int wave, int lane, int it_lo, int it_hi) {
  LAS float* scr = (LAS float*)(lds + wave * 8448);
  int it = it_lo + gw;
  if (it >= it_hi) return;
  ConvDesc cur = conv_desc(p, l, it);
  f32x4 v[8]; float gv[8];
  conv_load(cur, lane, v, gv);
  for (; it < it_hi; it += NGW) {
    const bool more = it + NGW < it_hi;
    ConvDesc nxt = cur; f32x4 v2[8]; float gv2[8];
    if (more) { nxt = conv_desc(p, l, it + NGW); conv_load(nxt, lane, v2, gv2); }
    __builtin_amdgcn_sched_barrier(0);
    conv_finish(cur, v, gv, scr, lane);
    if (more) { cur = nxt;
#pragma unroll
      for (int i = 0; i < 8; ++i) { v[i] = v2[i]; gv[i] = gv2[i]; } }
  }
}
DI void phase_init(KP p, int gw, int NGW, int lane, int row_lo) {
  bf16_t* XB = (bf16_t*)(p->ws + WS_XB); float* SS = (float*)(p->ws + WS_SS); float* RSM = (float*)(p->ws + WS_RSM);
  auto row_src = [&](int m) { return m < MTOK ? p->in[0] + (size_t)m * DM : p->in[1] + (size_t)(m - MTOK) * DM; };
  f32x4 nx[4];
  { const int m0 = row_lo + gw; if (m0 < MTOK + 2048) {
#pragma unroll
      for (int j = 0; j < 4; ++j) nx[j] = ((const f32x4*)row_src(m0))[lane + 64 * j]; } }
  for (int m = row_lo + gw; m < MTOK + 2048; m += NGW) {
    const bool isx = m < MTOK;
    f32x4 v[4]; float s = 0.f;
#pragma unroll
    for (int j = 0; j < 4; ++j) v[j] = nx[j];
    { const int mn = (m + NGW < MTOK + 2048) ? m + NGW : m;
#pragma unroll
      for (int j = 0; j < 4; ++j) nx[j] = ((const f32x4*)row_src(mn))[lane + 64 * j]; }
    __builtin_amdgcn_sched_barrier(0);
#pragma unroll
    for (int j = 0; j < 4; ++j) s += (v[j][0] * v[j][0] + v[j][1] * v[j][1]) + (v[j][2] * v[j][2] + v[j][3] * v[j][3]);
    s = wave_sum(s);
    u32x2* o8 = (u32x2*)(XB + (size_t)m * DM);
#pragma unroll
    for (int j = 0; j < 4; ++j) { u32x2 w; w.x = pkbf(v[j][0], v[j][1]); w.y = pkbf(v[j][2], v[j][3]); o8[lane + 64 * j] = w; }
    if (isx) {
      if (lane < 16) SS[(size_t)m * 16 + lane] = lane == 0 ? s : 0.f;
    } else if (lane == 0) RSM[m - MTOK] = __builtin_amdgcn_rsqf(s * (1.0f / 1024.0f) + RMS_EPS);
  }
}

DI void unpack8(const u32x4 u, float (&f)[8]) { f[0] = bflo(u.x); f[1] = bfhi(u.x); f[2] = bflo(u.y); f[3] = bfhi(u.y); f[4] = bflo(u.z); f[5] = bfhi(u.z); f[6] = bflo(u.w); f[7] = bfhi(u.w); }
DI void phase_prep_rwkv(KP p, int l, int hf, LAS unsigned char* lds, int tid, int bid, int G) {
  LAS float* ps = (LAS float*)lds;
  LAS float* vd = ps + 16 * 1280;
  LAS unsigned short* twb = (LAS unsigned short*)(vd + 16 * 32);
  LAS unsigned short* adb = twb + 16 * 40;
  LAS unsigned short* vdb = adb + 16 * 40;
  LAS _Float16* vdT = (LAS _Float16*)(vdb + 16 * 40);
  const bf16_t* P = (const bf16_t*)(p->ws + WS_U);
  _Float16* VF = (_Float16*)(p->ws + WS_VF); float* RKB = (float*)(p->ws + WS_RKB);
  const float* mu = p->in[8] + l * APROJ; const float* w0 = p->in[9] + l * AW; const float* w_up = p->in[10] + l * 32 * AW;
  const float* a0 = p->in[11] + l * AW; const float* a_up = p->in[12] + l * 32 * AW;
  const float* k_k = p->in[14] + l * AW; const float* k_a = p->in[15] + l * AW; const float* r_k = p->in[16] + l * AW;
  const float* v0 = p->in[19]; const float* v_down = p->in[20]; const float* v_up = p->in[21];
  const int lane = tid & 63, wv = tid >> 6, l15 = lane & 15, q4 = lane >> 4, hd = wv < 6 ? wv : 5;
  bf16x8 wf[4], af[4], vf[4]; float w0c[4], a0c[4], v0c[4], kkc[4], kac[4], rkc[4];
#pragma unroll
  for (int dt = 0; dt < 4; ++dt) {
    const int c = hd * 64 + dt * 16 + l15;
    const float* wp = w_up + (size_t)(8 * q4) * AW + c; const float* ap = a_up + (size_t)(8 * q4) * AW + c; const float* vp_ = v_up + (size_t)(8 * q4) * AW + c;
    u32x4 w; w.x = pkbf(wp[0], wp[AW]); w.y = pkbf(wp[2 * AW], wp[3 * AW]); w.z = pkbf(wp[4 * AW], wp[5 * AW]); w.w = pkbf(wp[6 * AW], wp[7 * AW]); wf[dt] = __builtin_bit_cast(bf16x8, w);
    u32x4 x; x.x = pkbf(ap[0], ap[AW]); x.y = pkbf(ap[2 * AW], ap[3 * AW]); x.z = pkbf(ap[4 * AW], ap[5 * AW]); x.w = pkbf(ap[6 * AW], ap[7 * AW]); af[dt] = __builtin_bit_cast(bf16x8, x);
    u32x4 y = (u32x4){0u, 0u, 0u, 0u};
    if (l == 1) { y.x = pkbf(vp_[0], vp_[AW]); y.y = pkbf(vp_[2 * AW], vp_[3 * AW]); y.z = pkbf(vp_[4 * AW], vp_[5 * AW]); y.w = pkbf(vp_[6 * AW], vp_[7 * AW]); }
    vf[dt] = __builtin_bit_cast(bf16x8, y);
    w0c[dt] = w0[c]; a0c[dt] = a0[c]; v0c[dt] = (l == 1) ? v0[c] : 0.f; kkc[dt] = k_k[c]; kac[dt] = k_a[c]; rkc[dt] = r_k[c];
  }
  if (l == 1) { for (int e = tid; e < 384 * 32; e += 512) { const int cc = e >> 5, j = e & 31; vdT[j * 392 + cc] = (_Float16)v_down[e]; } }
  for (int tile = bid; tile < 1024; tile += G) {
    const int b = tile >> 7, t0 = (tile & 127) * 16, tok0 = b * TSEQ + t0;
    _Float16* S6 = (_Float16*)s6_block(p, b * 6 + hd);
    for (int e = tid; e < 2560; e += 512) {
      const int i = e / 160, c8 = (e % 160) * 8;
      const size_t r = (size_t)(tok0 + i) * PW + c8;
      const u32x4 cur = *(const u32x4*)(P + r);
      u32x4 prv = (u32x4){0u, 0u, 0u, 0u};
      if (t0 + i > 0) prv = *(const u32x4*)(P + r - PW);
      float pc[8], pp[8]; unpack8(cur, pc); unpack8(prv, pp);
      const f32x4 m0 = *(const f32x4*)(mu + c8), m1 = *(const f32x4*)(mu + c8 + 4);
      f32x4 o0, o1;
#pragma unroll
      for (int j = 0; j < 4; ++j) { o0[j] = pc[j] + m0[j] * (pp[j] - pc[j]); o1[j] = pc[4 + j] + m1[j] * (pp[4 + j] - pc[4 + j]); }
      *(LAS f32x4*)(ps + i * 1280 + c8) = o0; *(LAS f32x4*)(ps + i * 1280 + c8 + 4) = o1;
    }
    _Float16 vfv[16];
#pragma unroll
    for (int i = 0; i < 4; ++i)
#pragma unroll
      for (int dt = 0; dt < 4; ++dt) vfv[i * 4 + dt] = (l == 1) ? VF[(size_t)(tok0 + 4 * q4 + i) * AW + hd * 64 + dt * 16 + l15] : (_Float16)0.f;
    __syncthreads();
    {
      const int i = tid >> 5, j = tid & 31;
      { const float xv = ps[i * 1280 + 1152 + j]; twb[i * 40 + j] = (unsigned short)(pkbf(1.0f - 2.0f / (1.0f + __expf(2.0f * xv)), 0.f) & 0xffffu); }
      adb[i * 40 + j] = (unsigned short)(pkbf(ps[i * 1280 + 1184 + j], 0.f) & 0xffffu);
      if (l == 1) {
        float s0 = 0.f, s1 = 0.f;
#pragma unroll 4
        for (int cc = 0; cc < 384; cc += 8) {
          const f32x4 pa = *(const LAS f32x4*)(ps + i * 1280 + 768 + cc), pb = *(const LAS f32x4*)(ps + i * 1280 + 768 + cc + 4);
          const h8_t hv = *(const LAS h8_t*)(vdT + j * 392 + cc);
          s0 += (pa[0] * (float)hv[0] + pa[1] * (float)hv[1]) + (pa[2] * (float)hv[2] + pa[3] * (float)hv[3]);
          s1 += (pb[0] * (float)hv[4] + pb[1] * (float)hv[5]) + (pb[2] * (float)hv[6] + pb[3] * (float)hv[7]);
        }
        vdb[i * 40 + j] = (unsigned short)(pkbf(s0 + s1, 0.f) & 0xffffu);
      }
    }
    __syncthreads();
    if (wv < 6) {
      const bf16x8 atw = *(const LAS bf16x8*)(twb + l15 * 40 + 8 * q4), aad = *(const LAS bf16x8*)(adb + l15 * 40 + 8 * q4);
      bf16x8 avd = atw; if (l == 1) avd = *(const LAS bf16x8*)(vdb + l15 * 40 + 8 * q4);
      f32x4 accw[4], acca[4], accv[4];
#pragma unroll
      for (int dt = 0; dt < 4; ++dt) {
        const f32x4 z4 = (f32x4){0.f, 0.f, 0.f, 0.f};
        accw[dt] = __builtin_amdgcn_mfma_f32_16x16x32_bf16(atw, wf[dt], z4, 0, 0, 0);
        acca[dt] = __builtin_amdgcn_mfma_f32_16x16x32_bf16(aad, af[dt], z4, 0, 0, 0);
        accv[dt] = z4; if (l == 1) accv[dt] = __builtin_amdgcn_mfma_f32_16x16x32_bf16(avd, vf[dt], z4, 0, 0, 0);
      }
#pragma unroll
      for (int i = 0; i < 4; ++i) {
        const int ti = 4 * q4 + i, tok = tok0 + ti, t = t0 + ti;
        float kkr[4], kp[4], rr[4], vp[4], aa4[4], om4[4]; float nsum = 0.f, rksum = 0.f;
#pragma unroll
        for (int dt = 0; dt < 4; ++dt) {
          const int c = hd * 64 + dt * 16 + l15;
          const float aw = w0c[dt] + accw[dt][i], aa = a0c[dt] + acca[dt][i], av = v0c[dt] + accv[dt][i];
          const float z = -aw; const float sp = fmaxf(z, 0.f) + __logf(1.0f + __expf(-fabsf(z)));
          const float e = __expf(-sp - 0.5f), xm = -e;
          float om = 1.0f / 40320.0f; om = om * xm + 1.0f / 5040.0f; om = om * xm + 1.0f / 720.0f; om = om * xm + 1.0f / 120.0f; om = om * xm + 1.0f / 24.0f; om = om * xm + 1.0f / 6.0f; om = om * xm + 0.5f; om = om * xm + 1.0f; om = om * xm;
          const float a = sigmoidf_(aa);
          const float r = ps[ti * 1280 + c], k = ps[ti * 1280 + 384 + c], v = ps[ti * 1280 + 768 + c];
          float vpp = v;
          if (l == 0) VF[(size_t)tok * AW + c] = (_Float16)v;
          else { const float vfl = (float)vfv[i * 4 + dt]; vpp = v + (vfl - v) * sigmoidf_(av); }
          kkr[dt] = k * kkc[dt]; nsum += kkr[dt] * kkr[dt];
          kp[dt] = k * (1.0f + (a - 1.0f) * kac[dt]); rksum += r * kp[dt] * rkc[dt];
          rr[dt] = r; vp[dt] = vpp; aa4[dt] = a; om4[dt] = om;
        }
        nsum = allreduce16(nsum); rksum = allreduce16(rksum);
        const float inv = __builtin_amdgcn_rcpf(fmaxf(__builtin_amdgcn_sqrtf(nsum), 1e-12f));
        const size_t base = ((size_t)t * 6) * 64 + l15;
#pragma unroll
        for (int dt = 0; dt < 4; ++dt) {
          const float kk = kkr[dt] * inv; const size_t o = base + dt * 16;
          S6[o] = (_Float16)rr[dt]; S6[o + 64] = (_Float16)kp[dt]; S6[o + 128] = (_Float16)vp[dt]; S6[o + 192] = (_Float16)kk; S6[o + 256] = (_Float16)(-(kk * aa4[dt])); S6[o + 320] = (_Float16)om4[dt];
        }
        if (l15 == 0) RKB[(size_t)(b * 6 + hd) * TSEQ + t] = rksum;
      }
    }
    __syncthreads();
  }
}

DI void transpose64(const bf16_t* src, size_t spitch, bf16_t* dst, size_t dpitch, LAS unsigned short* scr, int lane) {
#pragma unroll
  for (int it = 0; it < 8; ++it) {
    const int row = it * 8 + (lane >> 3), c8 = (lane & 7) * 8;
    const u32x4 v = *(const u32x4*)(src + (size_t)row * spitch + c8);
    LAS unsigned* d = (LAS unsigned*)(scr + row * 66 + c8);
    d[0] = v.x; d[1] = v.y; d[2] = v.z; d[3] = v.w;
  }
  LDS_WAIT();
#pragma unroll
  for (int t8 = 0; t8 < 8; ++t8) {
    unsigned w[4];
#pragma unroll
    for (int j = 0; j < 4; ++j) { const unsigned lo = scr[(t8 * 8 + 2 * j) * 66 + lane], hi = scr[(t8 * 8 + 2 * j + 1) * 66 + lane]; w[j] = lo | (hi << 16); }
    u32x4 o; o.x = w[0]; o.y = w[1]; o.z = w[2]; o.w = w[3];
    *(u32x4*)(dst + (size_t)lane * dpitch + t8 * 8) = o;
  }
  LDS_WAIT();
}
template <int PART> DI void phase_attn_prep(KP p, int l, LAS unsigned char* lds, int gw, int NGW, int wave, int lane) {
  bf16_t* P = (bf16_t*)(p->ws + WS_U);
  LAS unsigned short* scr = (LAS unsigned short*)(lds + wave * 8448);
  if constexpr (PART == 0) {
    const float* qg = p->in[22] + l * 64; const float* kg = p->in[23] + l * 64;
    const int cl = lane < 48 ? lane : 47, d0 = (cl & 7) * 8;
    float gg[8];
#pragma unroll
    for (int j = 0; j < 8; ++j) gg[j] = qg[d0 + j] * kg[d0 + j];
    for (int tok0 = gw; tok0 < MTOK; tok0 += 8 * NGW) {
      u32x4 rows[8];
#pragma unroll
      for (int q = 0; q < 8; ++q) { const int tok = tok0 + q * NGW; rows[q] = (tok < MTOK) ? *(const u32x4*)(P + (size_t)tok * PW + PK + cl * 8) : (u32x4){0u, 0u, 0u, 0u}; }
#pragma unroll
      for (int q = 0; q < 8; ++q) {
        const int tok = tok0 + q * NGW;
        float f[8]; unpack8(rows[q], f);
        float s = 0.f;
#pragma unroll
        for (int j = 0; j < 8; ++j) s += f[j] * f[j];
        s += __shfl_xor(s, 1); s += __shfl_xor(s, 2); s += __shfl_xor(s, 4);
        const float rs = __builtin_amdgcn_rsqf(s * (1.0f / 64.0f) + RMS_EPS);
        u32x4 o; o.x = pkbf(f[0] * rs * gg[0], f[1] * rs * gg[1]); o.y = pkbf(f[2] * rs * gg[2], f[3] * rs * gg[3]); o.z = pkbf(f[4] * rs * gg[4], f[5] * rs * gg[5]); o.w = pkbf(f[6] * rs * gg[6], f[7] * rs * gg[7]);
        if (lane < 48 && tok < MTOK) *(u32x4*)(P + (size_t)tok * PW + PK + cl * 8) = o;
      }
    }
  }
  if constexpr (PART == 0) {
    bf16_t* VTB = (bf16_t*)(p->ws + WS_VTB);
    for (int it = gw; it < 8 * 6 * 32; it += NGW) {
      const int tb = it & 31, h = (it >> 5) % 6, b = it / 192;
      transpose64(P + (size_t)(b * TSEQ + tb * 64) * PW + PV + h * 64, PW, VTB + (size_t)((b * 6 + h) * 64) * TSEQ + tb * 64, TSEQ, scr, lane);
    }
  }
  if constexpr (PART == 1) {
    const bf16_t* KVC = (const bf16_t*)(p->ws + WS_KVC); bf16_t* KNC = (bf16_t*)(p->ws + WS_KNC); bf16_t* VTC = (bf16_t*)(p->ws + WS_VTC);
    const float* qg = p->in[32] + l * 256; const float* kg = p->in[33] + l * 256;
    for (int it = gw; it < 2048 * 4; it += NGW) {
      const int row = it >> 2, h = it & 3;
      const u32x2 u = *(const u32x2*)(KVC + (size_t)row * 2048 + h * 256 + lane * 4);
      const float f0 = bflo(u.x), f1 = bfhi(u.x), f2 = bflo(u.y), f3 = bfhi(u.y);
      const float s = wave_sum((f0 * f0 + f1 * f1) + (f2 * f2 + f3 * f3));
      const float rs = __builtin_amdgcn_rsqf(s * (1.0f / 256.0f) + RMS_EPS);
      const f32x4 a = *(const f32x4*)(qg + lane * 4), bb = *(const f32x4*)(kg + lane * 4);
      u32x2 o; o.x = pkbf(f0 * rs * a[0] * bb[0], f1 * rs * a[1] * bb[1]); o.y = pkbf(f2 * rs * a[2] * bb[2], f3 * rs * a[3] * bb[3]);
      *(u32x2*)(KNC + (size_t)row * 1024 + h * 256 + lane * 4) = o;
    }
    for (int it = gw; it < 8 * 4 * 16; it += NGW) {
      const int mt = it & 3, dt = (it >> 2) & 3, h = (it >> 4) & 3, b = it >> 6;
      transpose64(KVC + (size_t)(b * 256 + mt * 64) * 2048 + 1024 + h * 256 + dt * 64, 2048, VTC + (size_t)((b * 4 + h) * 256 + dt * 64) * 256 + mt * 64, 256, scr, lane);
    }
  }
}

constexpr int SCAN_STEP_B = 1152, SCAN_CHUNK_B = 32 * SCAN_STEP_B;
DI void scan_issue(const unsigned char* src, int lt, u32x4 (&v)[6]) {
#pragma unroll
  for (int q = 0; q < 6; ++q) v[q] = *(const u32x4*)(src + (size_t)(q * 256 + lt) * 16);
}
DI void scan_write(const u32x4 (&v)[6], LAS unsigned char* dst, int lt) {
#pragma unroll
  for (int q = 0; q < 6; ++q) {
    const int e = (q * 256 + lt) * 8, t = e / 384, rem = e - t * 384, X = rem >> 6, c = rem & 63;
    LAS unsigned char* d = dst + t * SCAN_STEP_B;
    if (X == 1 || X == 4 || X == 5) {
      const h8_t hv = __builtin_bit_cast(h8_t, v[q]);
      f32x4 a, b; a[0] = (float)hv[0]; a[1] = (float)hv[1]; a[2] = (float)hv[2]; a[3] = (float)hv[3]; b[0] = (float)hv[4]; b[1] = (float)hv[5]; b[2] = (float)hv[6]; b[3] = (float)hv[7];
      LAS unsigned char* dd = d + (X == 1 ? 0 : X == 4 ? 256 : 512) + c * 4;
      *(LAS f32x4*)dd = a; *(LAS f32x4*)(dd + 16) = b;
    } else {
      *(LAS u32x4*)(d + (X == 0 ? 768 : X == 3 ? 896 : 1024) + c * 2) = v[q];
    }
  }
}
DI void phase_scan(KP p, int hf, LAS unsigned char* lds, int tid, int bid) {
  if (bid >= 192) return;
  const int bh = bid >> 2, rg = bid & 3, b = bh / 6, h = bh % 6;
  const int wave = tid >> 6, lane = tid & 63;
  LAS unsigned char* buf = lds;
  const unsigned char* S6 = s6_block(p, bh);
  const float* RKB = (const float*)(p->ws + WS_RKB) + (size_t)bh * TSEQ;
  _Float16* YH = (_Float16*)(p->ws + WS_YH); _Float16* BON = (_Float16*)(p->ws + WS_BON);
  bool is_comp = wave < 4; int widx = wave & 3;
  {
    LAS int* roles = (LAS int*)(lds + 2 * SCAN_CHUNK_B);
    const int simd = (int)__builtin_amdgcn_s_getreg((1 << 11) | (4 << 6) | 4);
    if (lane == 0) roles[wave] = simd;
    __syncthreads();
    int sid[8], rk[8], nfirst = 0;
#pragma unroll
    for (int w = 0; w < 8; ++w) sid[w] = roles[w];
#pragma unroll
    for (int w = 0; w < 8; ++w) { int r = 0;
#pragma unroll
      for (int u = 0; u < 8; ++u) if (u < w && sid[u] == sid[w]) ++r;
      rk[w] = r; nfirst += (r == 0); }
    if (nfirst == 4) {
      int myr = 0, ci = 0, li = 0;
#pragma unroll
      for (int w = 0; w < 8; ++w) { if (w == wave) myr = rk[w]; if (w < wave) { ci += (rk[w] == 0); li += (rk[w] != 0); } }
      is_comp = (myr == 0); widx = is_comp ? ci : li;
    }
    __syncthreads();
  }
  const int kq = lane & 15, v = 16 * rg + 4 * widx + (lane >> 4);
  f32x2 S01 = {0.f, 0.f}, S23 = {0.f, 0.f};
  const int lt = widx * 64 + lane;
  u32x4 R[6]; unsigned bvv = 0u; float brk = 0.f;
  const int bt = lt >> 3, br2 = (lt & 7) * 2;
  if (!is_comp) {
    scan_issue(S6, lt, R); scan_write(R, buf, lt); scan_issue(S6 + 24576, lt, R);
    bvv = *(const unsigned*)(S6 + ((size_t)(bt * 6 + 2) * 64 + 16 * rg + br2) * 2); brk = RKB[bt];
  }

  __syncthreads();
  const size_t obase = (size_t)(b * TSEQ) * AW + h * 64;
  h4_t rp4 = {(_Float16)0.f, (_Float16)0.f, (_Float16)0.f, (_Float16)0.f}; float ykeep = 0.f;
  for (int ch = 0; ch < 64; ++ch) {
    if (!is_comp) {
      if (ch + 1 < 64) scan_write(R, buf + ((ch + 1) & 1) * SCAN_CHUNK_B, lt);
      if (ch + 2 < 64) scan_issue(S6 + (size_t)(ch + 2) * 24576, lt, R);
      {
        const h4_t hv = __builtin_bit_cast(h4_t, (u32x2){bvv, 0u});
        typedef _Float16 h2_t __attribute__((ext_vector_type(2)));
        h2_t o; o[0] = (_Float16)(brk * (float)hv[0]); o[1] = (_Float16)(brk * (float)hv[1]);
        *(h2_t*)(BON + obase + (size_t)(ch * 32 + bt) * AW + 16 * rg + br2) = o;
        if (ch + 1 < 64) { bvv = *(const unsigned*)(S6 + (size_t)(ch + 1) * 24576 + ((size_t)(bt * 6 + 2) * 64 + 16 * rg + br2) * 2); brk = RKB[(ch + 1) * 32 + bt]; }
      }
    } else {
      const LAS unsigned char* cb = buf + (ch & 1) * SCAN_CHUNK_B;
      f32x4 k4 = *(const LAS f32x4*)(cb + kq * 16), nb4 = *(const LAS f32x4*)(cb + 256 + kq * 16), nom4 = *(const LAS f32x4*)(cb + 512 + kq * 16);
      h4_t r4 = *(const LAS h4_t*)(cb + 768 + kq * 8), kk4 = *(const LAS h4_t*)(cb + 896 + kq * 8);
      _Float16 vh = *(const LAS _Float16*)(cb + 1024 + v * 2);
      f32x4 k4n = *(const LAS f32x4*)(cb + SCAN_STEP_B + kq * 16), nb4n = *(const LAS f32x4*)(cb + SCAN_STEP_B + 256 + kq * 16), nom4n = *(const LAS f32x4*)(cb + SCAN_STEP_B + 512 + kq * 16);
      h4_t r4n = *(const LAS h4_t*)(cb + SCAN_STEP_B + 768 + kq * 8), kk4n = *(const LAS h4_t*)(cb + SCAN_STEP_B + 896 + kq * 8);
      _Float16 vhn = *(const LAS _Float16*)(cb + SCAN_STEP_B + 1024 + v * 2);
#pragma unroll 8
      for (int s = 0; s < 32; ++s) {
        const LAS unsigned char* sb = cb + (s + 2 < 32 ? s + 2 : 31) * SCAN_STEP_B;
        const f32x4 k4m = *(const LAS f32x4*)(sb + kq * 16), nb4m = *(const LAS f32x4*)(sb + 256 + kq * 16), nom4m = *(const LAS f32x4*)(sb + 512 + kq * 16);
        const h4_t r4m = *(const LAS h4_t*)(sb + 768 + kq * 8), kk4m = *(const LAS h4_t*)(sb + 896 + kq * 8);
        const _Float16 vhm = *(const LAS _Float16*)(sb + 1024 + v * 2);
        __builtin_amdgcn_sched_barrier(0);
        const float vv = (float)vh;
        float sa = __builtin_fmaf(S01[0], (float)kk4[0], 0.f), y = __builtin_fmaf(S01[0], (float)rp4[0], 0.f);
        sa = __builtin_fmaf(S01[1], (float)kk4[1], sa); y = __builtin_fmaf(S01[1], (float)rp4[1], y);
        sa = __builtin_fmaf(S23[0], (float)kk4[2], sa); y = __builtin_fmaf(S23[0], (float)rp4[2], y);
        sa = __builtin_fmaf(S23[1], (float)kk4[3], sa); y = __builtin_fmaf(S23[1], (float)rp4[3], y);
        float t0 = vfma(vv, k4[0], S01[0]), t1 = vfma(vv, k4[1], S01[1]), t2 = vfma(vv, k4[2], S23[0]), t3 = vfma(vv, k4[3], S23[1]);
        sa = dpp_addx<0xB1>(sa); y = dpp_addx<0xB1>(y); sa = dpp_addx<0x4E>(sa); y = dpp_addx<0x4E>(y);
        sa = dpp_addx<0x141>(sa); y = dpp_addx<0x141>(y); sa = dpp_addx<0x140>(sa); y = dpp_addx<0x140>(y);
        t0 = vfma(sa, nb4[0], t0); t1 = vfma(sa, nb4[1], t1); t2 = vfma(sa, nb4[2], t2); t3 = vfma(sa, nb4[3], t3);
        S01[0] = vfma(nom4[0], S01[0], t0); S01[1] = vfma(nom4[1], S01[1], t1); S23[0] = vfma(nom4[2], S23[0], t2); S23[1] = vfma(nom4[3], S23[1], t3);
        ykeep = (kq == ((s + 15) & 15)) ? y : ykeep;
        if ((s & 15) == 0 && (ch | s) != 0) YH[obase + (size_t)(ch * 32 + s - 16 + kq) * AW + v] = (_Float16)ykeep;
        rp4 = r4; k4 = k4n; nb4 = nb4n; nom4 = nom4n; r4 = r4n; kk4 = kk4n; vh = vhn;
        k4n = k4m; nb4n = nb4m; nom4n = nom4m; r4n = r4m; kk4n = kk4m; vhn = vhm;
        __builtin_amdgcn_sched_barrier(0);
      }
    }
    asm volatile("s_waitcnt lgkmcnt(0)" ::: "memory"); __builtin_amdgcn_s_barrier(); asm volatile("" ::: "memory");
  }
  if (is_comp) {
    float y = S01[0] * (float)rp4[0]; y = __builtin_fmaf(S01[1], (float)rp4[1], y); y = __builtin_fmaf(S23[0], (float)rp4[2], y); y = __builtin_fmaf(S23[1], (float)rp4[3], y);
    y = allreduce16(y);
    ykeep = (kq == 15) ? y : ykeep;
    YH[obase + (size_t)(TSEQ - 16 + kq) * AW + v] = (_Float16)ykeep;
  }

}

#define MFMA32(a, b, c) __builtin_amdgcn_mfma_f32_32x32x16_bf16((a), (b), (c), 0, 0, 0)
constexpr float LOG2E = 1.4426950408889634f;
DI int crow(int r, int hi) { return (r & 3) + 8 * (r >> 2) + 4 * hi; }
DI bf16x8 pack8(const f32x16& x, int s) {
  u32x4 pk; pk.x = pkbf(x[8 * s], x[8 * s + 1]); pk.y = pkbf(x[8 * s + 2], x[8 * s + 3]); pk.z = pkbf(x[8 * s + 4], x[8 * s + 5]); pk.w = pkbf(x[8 * s + 6], x[8 * s + 7]);
  return __builtin_bit_cast(bf16x8, pk);
}
DI bf16x8 ld2x4(const bf16_t* p0) {
  const u32x2 a = *(const u32x2*)p0, b = *(const u32x2*)(p0 + 8);
  u32x4 r; r.x = a.x; r.y = a.y; r.z = b.x; r.w = b.y; return __builtin_bit_cast(bf16x8, r);
}
DI float sumsq8(const bf16x8 v) { const u32x4 u = __builtin_bit_cast(u32x4, v); float f[8]; unpack8(u, f); float s = 0.f;
#pragma unroll
  for (int j = 0; j < 8; ++j) s += f[j] * f[j];
  return s; }
DI void chunk_attn_task(const bf16_t* P, const bf16_t* VTB, bf16_t* Y, const LAS float* biasl, int task, int lane) {
  const int n = task & 31, bhh = task >> 5, h = bhh % 6, b = bhh / 6;
  const int c = lane & 31, hh = lane >> 5;
  bf16x8 qb[2][4]; float sc[2], m[2], lsum[2]; f32x16 o0[2], o1[2];
#pragma unroll
  for (int qh = 0; qh < 2; ++qh) {
    const int qpos = n * 64 + qh * 32 + c;
    const bf16_t* qp = P + (size_t)(b * TSEQ + qpos) * PW + PQ + h * 64 + 8 * hh;
    float sq = 0.f;
#pragma unroll
    for (int s = 0; s < 4; ++s) { qb[qh][s] = *(const bf16x8*)(qp + 16 * s); sq += sumsq8(qb[qh][s]); }
    sq += __shfl_xor(sq, 32);
    sc[qh] = __builtin_amdgcn_rsqf(sq * (1.0f / 64.0f) + RMS_EPS) * 0.125f * LOG2E;
    m[qh] = -1e30f; lsum[qh] = 0.f;
#pragma unroll
    for (int i = 0; i < 16; ++i) { o0[qh][i] = 0.f; o1[qh][i] = 0.f; }
  }
  const int kt0 = (n > 8 ? n - 8 : 0) * 2, kt1 = (n + 1) * 2;
  const bf16_t* Kb = P + (size_t)(b * TSEQ + c) * PW + PK + h * 64 + 8 * hh;
  const bf16_t* Vt = VTB + ((size_t)(b * 6 + h) * 64 + c) * TSEQ + 4 * hh;
  const LAS float* bias = biasl + h * 320;
  bf16x8 ka[4], va[2][2];
#pragma unroll
  for (int s = 0; s < 4; ++s) ka[s] = *(const bf16x8*)(Kb + (size_t)(kt0 * 32) * PW + 16 * s);
#pragma unroll
  for (int dt = 0; dt < 2; ++dt)
#pragma unroll
    for (int s2 = 0; s2 < 2; ++s2) va[dt][s2] = ld2x4(Vt + (size_t)dt * 32 * TSEQ + kt0 * 32 + 16 * s2);
#pragma unroll 1
  for (int kt = kt0; kt < kt1; ++kt) {
    const int key0 = kt * 32, keyn = (kt + 1 < kt1 ? kt + 1 : kt) * 32;
    bf16x8 kan[4], van[2][2];
#pragma unroll
    for (int s = 0; s < 4; ++s) kan[s] = *(const bf16x8*)(Kb + (size_t)keyn * PW + 16 * s);
#pragma unroll
    for (int dt = 0; dt < 2; ++dt)
#pragma unroll
      for (int s2 = 0; s2 < 2; ++s2) van[dt][s2] = ld2x4(Vt + (size_t)dt * 32 * TSEQ + keyn + 16 * s2);
    __builtin_amdgcn_sched_barrier(0);
#pragma unroll
    for (int qh = 0; qh < 2; ++qh) {
      const int qpos = n * 64 + qh * 32 + c;
      f32x16 st;
#pragma unroll
      for (int i = 0; i < 16; ++i) st[i] = 0.f;
#pragma unroll
      for (int s = 0; s < 4; ++s) st = MFMA32(ka[s], qb[qh][s], st);
      float tmax = -1e30f;
      const int qlo = n * 64 + qh * 32;
      if (qlo - (key0 + 31) >= 256) {
        const float bc = bias[319];
#pragma unroll
        for (int i = 0; i < 16; ++i) { st[i] = __builtin_fmaf(st[i], sc[qh], bc); tmax = fmaxf(tmax, st[i]); }
      } else if (qlo + 31 - key0 <= 256) {
        const LAS float* bp = bias + (qpos - key0 - 4 * hh + 63);
#pragma unroll
        for (int i = 0; i < 16; ++i) { st[i] = __builtin_fmaf(st[i], sc[qh], bp[-((i & 3) + 8 * (i >> 2))]); tmax = fmaxf(tmax, st[i]); }
      } else {
#pragma unroll
        for (int i = 0; i < 16; ++i) {
          const int rel = qpos - (key0 + crow(i, hh)); const int idx = (rel > 256 ? 256 : rel) + 63;
          st[i] = __builtin_fmaf(st[i], sc[qh], bias[idx]); tmax = fmaxf(tmax, st[i]);
        }
      }
      tmax = fmaxf(tmax, __shfl_xor(tmax, 32));
      const float mn = fmaxf(m[qh], tmax), alpha = __builtin_amdgcn_exp2f(m[qh] - mn); m[qh] = mn;
      float psum = 0.f;
#pragma unroll
      for (int i = 0; i < 16; ++i) { st[i] = __builtin_amdgcn_exp2f(st[i] - mn); psum += st[i]; }
      lsum[qh] = lsum[qh] * alpha + psum;
      if (__builtin_amdgcn_ballot_w64(alpha != 1.0f) != 0ull) {
#pragma unroll
        for (int i = 0; i < 16; ++i) { o0[qh][i] *= alpha; o1[qh][i] *= alpha; } }
      const bf16x8 p0 = pack8(st, 0), p1 = pack8(st, 1);
      o0[qh] = MFMA32(va[0][0], p0, o0[qh]); o0[qh] = MFMA32(va[0][1], p1, o0[qh]);
      o1[qh] = MFMA32(va[1][0], p0, o1[qh]); o1[qh] = MFMA32(va[1][1], p1, o1[qh]);
    }
#pragma unroll
    for (int s = 0; s < 4; ++s) ka[s] = kan[s];
    va[0][0] = van[0][0]; va[0][1] = van[0][1]; va[1][0] = van[1][0]; va[1][1] = van[1][1];
  }
#pragma unroll
  for (int qh = 0; qh < 2; ++qh) {
    const int qpos = n * 64 + qh * 32 + c;
    float ls = lsum[qh]; ls += __shfl_xor(ls, 32);
    const float linv = 1.0f / ls;
    bf16_t* yp = Y + (size_t)(b * TSEQ + qpos) * DM + 384 + h * 64 + 4 * hh;
#pragma unroll
    for (int g = 0; g < 4; ++g) {
      u32x2 w; w.x = pkbf(o0[qh][4 * g] * linv, o0[qh][4 * g + 1] * linv); w.y = pkbf(o0[qh][4 * g + 2] * linv, o0[qh][4 * g + 3] * linv); *(u32x2*)(yp + 8 * g) = w;
      u32x2 w1; w1.x = pkbf(o1[qh][4 * g] * linv, o1[qh][4 * g + 1] * linv); w1.y = pkbf(o1[qh][4 * g + 2] * linv, o1[qh][4 * g + 3] * linv); *(u32x2*)(yp + 32 + 8 * g) = w1;
    }
  }
}
DI void phase_chunk(KP p, int l, LAS unsigned char* lds, int tid, int gw, int NGW, int lo, int hi) {
  const int lane = tid & 63;
  const bf16_t* P = (const bf16_t*)(p->ws + WS_U); bf16_t* Y = (bf16_t*)(p->ws + WS_Y);
  LAS float* biasl = (LAS float*)lds;
  for (int i = tid; i < 6 * 320; i += 512) biasl[i] = p->in[24][l * 1920 + i] * LOG2E;
  __syncthreads();
  for (int it = lo + gw; it < hi; it += NGW) {
    const int bhh = it % 48, n = 31 - (it / 48);
    chunk_attn_task(P, (const bf16_t*)(p->ws + WS_VTB), Y, biasl, bhh * 32 + n, lane);
  }
}
DI void phase_attn(KP p, int l, LAS unsigned char* lds, int tid, int gw, int NGW, int bid, int G) {
  const int lane = tid & 63;
  const bf16_t* P = (const bf16_t*)(p->ws + WS_U); bf16_t* Y = (bf16_t*)(p->ws + WS_Y);
  LAS float* biasl = (LAS float*)lds;
  LAS float* pl = (LAS float*)(lds + 8192);
  LAS float* ub = (LAS float*)(lds + 8192 + 16384);
  for (int i = tid; i < 6 * 320; i += 512) biasl[i] = p->in[24][l * 1920 + i] * LOG2E;
  __syncthreads();
  {
    const float* pw = p->in[25] + (size_t)l * 4 * 64 * 64; const float* pscale = p->in[26] + l * 256;
    LAS unsigned short* plb = (LAS unsigned short*)pl;
    const int pwv = tid >> 6, pg = pwv & 3, pl15 = lane & 15, pq4 = lane >> 4;
    bf16x8 pf[2][2]; float psc[2];
#pragma unroll
    for (int dd = 0; dd < 2; ++dd) {
      const int dcol = ((pwv >> 2) * 2 + dd) * 16 + pl15;
      psc[dd] = pscale[pg * 64 + dcol];
#pragma unroll
      for (int s2 = 0; s2 < 2; ++s2) {
        const float* wp = pw + (size_t)pg * 4096 + (size_t)(32 * s2 + 8 * pq4) * 64 + dcol;
        u32x4 w; w.x = pkbf(wp[0], wp[64]); w.y = pkbf(wp[128], wp[192]); w.z = pkbf(wp[256], wp[320]); w.w = pkbf(wp[384], wp[448]);
        pf[dd][s2] = __builtin_bit_cast(bf16x8, w);
      }
    }
    u32x4 pr0 = (u32x4){0u, 0u, 0u, 0u}, pr1 = (u32x4){0u, 0u, 0u, 0u};
    auto pool_fetch = [&](int tile, u32x4& r0, u32x4& r1) {
      const int tok0 = tile * 16, t0 = tok0 & (TSEQ - 1);
      { const int e = tid, rr = e >> 5, c8 = (e & 31) * 8, dt = rr - 15; r0 = (u32x4){0u, 0u, 0u, 0u}; if (t0 + dt >= 0) r0 = *(const u32x4*)(P + (size_t)(tok0 + dt) * PW + PC + c8); }
      { const int e = tid + 512, rr = e >> 5, c8 = (e & 31) * 8, dt = rr - 15; r1 = (u32x4){0u, 0u, 0u, 0u}; if (e < 31 * 32 && t0 + dt >= 0) r1 = *(const u32x4*)(P + (size_t)(tok0 + dt) * PW + PC + c8); }
    };
    if (bid < 1024) pool_fetch(bid, pr0, pr1);
    for (int r2 = 0; r2 < (REPK == 62 ? 2 : 1); ++r2)
    for (int tile = bid; tile < 1024; tile += G) {
      const int tok0 = tile * 16, t0 = tok0 & (TSEQ - 1);
      { float f[8]; unpack8(pr0, f); const int e = tid, rr = e >> 5, c8 = (e & 31) * 8;
        f32x4 a, b2; a[0] = f[0]; a[1] = f[1]; a[2] = f[2]; a[3] = f[3]; b2[0] = f[4]; b2[1] = f[5]; b2[2] = f[6]; b2[3] = f[7];
        *(LAS f32x4*)(ub + rr * 256 + c8) = a; *(LAS f32x4*)(ub + rr * 256 + c8 + 4) = b2; }
      if (tid + 512 < 31 * 32) { float f[8]; unpack8(pr1, f); const int e = tid + 512, rr = e >> 5, c8 = (e & 31) * 8;
        f32x4 a, b2; a[0] = f[0]; a[1] = f[1]; a[2] = f[2]; a[3] = f[3]; b2[0] = f[4]; b2[1] = f[5]; b2[2] = f[6]; b2[3] = f[7];
        *(LAS f32x4*)(ub + rr * 256 + c8) = a; *(LAS f32x4*)(ub + rr * 256 + c8 + 4) = b2; }
      __syncthreads();
      { const int nt = (tile + G < 1024) ? tile + G : tile; pool_fetch(nt, pr0, pr1); }
      __builtin_amdgcn_sched_barrier(0);
#pragma unroll
      for (int k = 0; k < 8; ++k) {
        const int e = tid + 512 * k, i = e >> 8, c = e & 255, g = c >> 6, win = 2 << g;
        const int t = t0 + i, cnt = (t + 1 < win) ? t + 1 : win;
        float s = 0.f;
        for (int jj = 0; jj < win; ++jj) s += ub[(i + 15 - jj) * 256 + c];
        plb[i * 264 + c] = (unsigned short)(pkbf(s / (float)cnt - ub[(i + 15) * 256 + c], 0.f) & 0xffffu);
      }
      __syncthreads();
      {
        const bf16x8 a0 = *(const LAS bf16x8*)(plb + pl15 * 264 + pg * 64 + 8 * pq4), a1 = *(const LAS bf16x8*)(plb + pl15 * 264 + pg * 64 + 32 + 8 * pq4);
#pragma unroll
        for (int dd = 0; dd < 2; ++dd) {
          f32x4 acc = (f32x4){0.f, 0.f, 0.f, 0.f};
          acc = __builtin_amdgcn_mfma_f32_16x16x32_bf16(a0, pf[dd][0], acc, 0, 0, 0);
          acc = __builtin_amdgcn_mfma_f32_16x16x32_bf16(a1, pf[dd][1], acc, 0, 0, 0);
          const int dcol = ((pwv >> 2) * 2 + dd) * 16 + pl15;
#pragma unroll
          for (int i = 0; i < 4; ++i) Y[(size_t)(tok0 + 4 * pq4 + i) * DM + 768 + pg * 64 + dcol] = (bf16_t)(pkbf(acc[i] * psc[dd], 0.f) & 0xffffu);
        }
      }
      __syncthreads();
    }
  }
  {
    const _Float16* YH = (const _Float16*)(p->ws + WS_YH); const _Float16* BON = (const _Float16*)(p->ws + WS_BON);
    const float* mu = p->in[8] + l * APROJ; const float* g_up = p->in[13] + (size_t)l * 64 * AW; const float* gn_g = p->in[17] + l * AW; const float* gn_b = p->in[18] + l * AW;
    LAS unsigned short* sgb = (LAS unsigned short*)(lds + 8192);
    const int wv = tid >> 6, l15 = lane & 15, q4 = lane >> 4, hd = wv < 6 ? wv : 5;
    bf16x8 gf[4][2];
#pragma unroll
    for (int dt = 0; dt < 4; ++dt)
#pragma unroll
      for (int s2 = 0; s2 < 2; ++s2) {
        const float* gp = g_up + (size_t)(32 * s2 + 8 * q4) * AW + hd * 64 + dt * 16 + l15;
        u32x4 w; w.x = pkbf(gp[0], gp[AW]); w.y = pkbf(gp[2 * AW], gp[3 * AW]); w.z = pkbf(gp[4 * AW], gp[5 * AW]); w.w = pkbf(gp[6 * AW], gp[7 * AW]);
        gf[dt][s2] = __builtin_bit_cast(bf16x8, w);
      }
    float gng[4], gnb[4];
#pragma unroll
    for (int dt = 0; dt < 4; ++dt) { gng[dt] = gn_g[hd * 64 + dt * 16 + l15]; gnb[dt] = gn_b[hd * 64 + dt * 16 + l15]; }
    bf16_t gcur[2], gprv[2]; _Float16 yv[16], bv[16], yn[16], bn[16];
    const float mul0 = mu[1216 + (tid & 63)];
    auto fin_fetch = [&](int tile, bf16_t (&gc)[2], bf16_t (&gp)[2], _Float16 (&y)[16], _Float16 (&bb)[16]) {
      const int tok0 = tile * 16;
#pragma unroll
      for (int q = 0; q < 2; ++q) { const int e = tid + 512 * q, i = e >> 6, j = e & 63, tok = tok0 + i, t = tok & (TSEQ - 1);
        gc[q] = P[(size_t)tok * PW + 1216 + j]; gp[q] = t > 0 ? P[(size_t)(tok - 1) * PW + 1216 + j] : (bf16_t)0; }
#pragma unroll
      for (int i = 0; i < 4; ++i)
#pragma unroll
        for (int dt = 0; dt < 4; ++dt) { const size_t o = (size_t)(tok0 + 4 * q4 + i) * AW + hd * 64 + dt * 16 + l15; y[i * 4 + dt] = YH[o]; bb[i * 4 + dt] = BON[o]; }
    };
    fin_fetch(bid, gcur, gprv, yv, bv);
    for (int r3 = 0; r3 < (REPK == 63 ? 2 : 1); ++r3)
    for (int tile = bid; tile < 1024; tile += G) {
      const int tok0 = tile * 16;
#pragma unroll
      for (int q = 0; q < 2; ++q) { const int e = tid + 512 * q; const float gc = bf2f(gcur[q]), gp = bf2f(gprv[q]); sgb[(e >> 6) * 72 + (e & 63)] = (unsigned short)(pkbf(sigmoidf_(gc + mul0 * (gp - gc)), 0.f) & 0xffffu); }
      __syncthreads();
      { const int nt = (tile + G < 1024) ? tile + G : tile; fin_fetch(nt, gcur, gprv, yn, bn); }
      __builtin_amdgcn_sched_barrier(0);
      if (wv < 6) {
        const bf16x8 a0 = *(const LAS bf16x8*)(sgb + l15 * 72 + 8 * q4), a1 = *(const LAS bf16x8*)(sgb + l15 * 72 + 32 + 8 * q4);
        f32x4 gacc[4];
#pragma unroll
        for (int dt = 0; dt < 4; ++dt) {
          gacc[dt] = (f32x4){0.f, 0.f, 0.f, 0.f};
          gacc[dt] = __builtin_amdgcn_mfma_f32_16x16x32_bf16(a0, gf[dt][0], gacc[dt], 0, 0, 0);
          gacc[dt] = __builtin_amdgcn_mfma_f32_16x16x32_bf16(a1, gf[dt][1], gacc[dt], 0, 0, 0);
        }
#pragma unroll
        for (int i = 0; i < 4; ++i) {
          const size_t tok = tok0 + 4 * q4 + i;
          float y[4], sum = 0.f;
#pragma unroll
          for (int dt = 0; dt < 4; ++dt) { y[dt] = (float)yv[i * 4 + dt]; sum += y[dt]; }
          const float mean = allreduce16(sum) * (1.0f / 64.0f);
          float var = 0.f;
#pragma unroll
          for (int dt = 0; dt < 4; ++dt) { y[dt] -= mean; var += y[dt] * y[dt]; }
          const float rs = __builtin_amdgcn_rsqf(allreduce16(var) * (1.0f / 64.0f) + 64e-5f);
#pragma unroll
          for (int dt = 0; dt < 4; ++dt) {
            const float o = (y[dt] * rs * gng[dt] + gnb[dt] + (float)bv[i * 4 + dt]) * gacc[dt][i];
            Y[tok * DM + hd * 64 + dt * 16 + l15] = (bf16_t)(pkbf(o, 0.f) & 0xffffu);
          }
        }
      }
#pragma unroll
      for (int i = 0; i < 16; ++i) { yv[i] = yn[i]; bv[i] = bn[i]; }
      __syncthreads();
    }
  }
}

constexpr int XK_PITCH = 528, XV_PITCH = 80, XK_BYTES = 32 * XK_PITCH, XV_BYTES = 256 * XV_PITCH, XBUF = XK_BYTES + XV_BYTES;
DI void phase_xattn(KP p, LAS unsigned char* lds, int tid, int bid, int G) {
  const bf16_t* QC = (const bf16_t*)(p->ws + WS_U); bf16_t* OC = (bf16_t*)(p->ws + WS_U + (size_t)MTOK * DM * 2);
  const bf16_t* KNC = (const bf16_t*)(p->ws + WS_KNC); const bf16_t* VTC = (const bf16_t*)(p->ws + WS_VTC);
  const int lane = tid & 63, wave = tid >> 6, c = lane & 31, hh = lane >> 5, qb = wave >> 1, dh = wave & 1;
  const int lk = tid >> 4, lp = tid & 15, ld = tid >> 1, lh = tid & 1;
  for (int u = bid; u < 512; u += G) {
    const int b = u >> 6, h = (u >> 4) & 3, qg = u & 15;
    const size_t qrow = (size_t)(b * TSEQ + qg * 128 + qb * 32 + c);
    const bf16_t* qp = QC + qrow * DM + h * 256 + 8 * hh;
    bf16x8 qreg[16]; float sq = 0.f;
#pragma unroll
    for (int s = 0; s < 16; ++s) { qreg[s] = *(const bf16x8*)(qp + 16 * s); sq += sumsq8(qreg[s]); }
    sq += __shfl_xor(sq, 32);
    const float sc = __builtin_amdgcn_rsqf(sq * (1.0f / 256.0f) + RMS_EPS) * 0.0625f * LOG2E;
    const bf16_t* ksrc = KNC + (size_t)(b * 256 + lk) * 1024 + h * 256 + lp * 16;
    const bf16_t* vsrc = VTC + ((size_t)(b * 4 + h) * 256 + ld) * 256 + lh * 16;
    u32x4 kr0 = *(const u32x4*)ksrc, kr1 = *(const u32x4*)(ksrc + 8), vr0 = *(const u32x4*)vsrc, vr1 = *(const u32x4*)(vsrc + 8);
    __syncthreads();
    { LAS unsigned char* kb = lds + lk * XK_PITCH + lp * 32; *(LAS u32x4*)kb = kr0; *(LAS u32x4*)(kb + 16) = kr1;
      LAS unsigned char* vb = lds + XK_BYTES + ld * XV_PITCH + lh * 32; *(LAS u32x4*)vb = vr0; *(LAS u32x4*)(vb + 16) = vr1; }
    __syncthreads();
    f32x16 o[4];
#pragma unroll
    for (int dt = 0; dt < 4; ++dt)
#pragma unroll
      for (int i = 0; i < 16; ++i) o[dt][i] = 0.f;
    float m = -1e30f, lsum = 0.f;
#pragma unroll 1
    for (int kt = 0; kt < 8; ++kt) {
      if (kt + 1 < 8) { const bf16_t* ks = ksrc + (size_t)(kt + 1) * 32 * 1024; const bf16_t* vs = vsrc + (kt + 1) * 32;
        kr0 = *(const u32x4*)ks; kr1 = *(const u32x4*)(ks + 8); vr0 = *(const u32x4*)vs; vr1 = *(const u32x4*)(vs + 8); }
      const LAS unsigned char* kbase = lds + (kt & 1) * XBUF + c * XK_PITCH + hh * 16;
      const LAS unsigned char* vbase = lds + (kt & 1) * XBUF + XK_BYTES + (dh * 128 + c) * XV_PITCH + hh * 8;
      f32x16 st;
#pragma unroll
      for (int i = 0; i < 16; ++i) st[i] = 0.f;
#pragma unroll
      for (int s = 0; s < 16; ++s) st = MFMA32(*(const LAS bf16x8*)(kbase + s * 32), qreg[s], st);
      float tmax = -1e30f;
#pragma unroll
      for (int i = 0; i < 16; ++i) { st[i] *= sc; tmax = fmaxf(tmax, st[i]); }
      tmax = fmaxf(tmax, __shfl_xor(tmax, 32));
      const float mn = fmaxf(m, tmax), alpha = __builtin_amdgcn_exp2f(m - mn); m = mn;
      float psum = 0.f;
#pragma unroll
      for (int i = 0; i < 16; ++i) { st[i] = __builtin_amdgcn_exp2f(st[i] - mn); psum += st[i]; }
      lsum = lsum * alpha + psum;
      const bf16x8 p0 = pack8(st, 0), p1 = pack8(st, 1);
      const bool resc = __builtin_amdgcn_ballot_w64(alpha != 1.0f) != 0ull;
#pragma unroll
      for (int dt = 0; dt < 4; ++dt) {
        if (resc) {
#pragma unroll
          for (int i = 0; i < 16; ++i) o[dt][i] *= alpha; }
        const LAS unsigned char* vp = vbase + dt * 32 * XV_PITCH;
        const u32x2 a0 = *(const LAS u32x2*)vp, a1 = *(const LAS u32x2*)(vp + 16), a2 = *(const LAS u32x2*)(vp + 32), a3 = *(const LAS u32x2*)(vp + 48);
        u32x4 w0; w0.x = a0.x; w0.y = a0.y; w0.z = a1.x; w0.w = a1.y;
        u32x4 w1; w1.x = a2.x; w1.y = a2.y; w1.z = a3.x; w1.w = a3.y;
        o[dt] = MFMA32(__builtin_bit_cast(bf16x8, w0), p0, o[dt]);
        o[dt] = MFMA32(__builtin_bit_cast(bf16x8, w1), p1, o[dt]);
      }
      if (kt + 1 < 8) {
        LAS unsigned char* nb = lds + ((kt + 1) & 1) * XBUF;
        LAS unsigned char* kb = nb + lk * XK_PITCH + lp * 32; *(LAS u32x4*)kb = kr0; *(LAS u32x4*)(kb + 16) = kr1;
        LAS unsigned char* vb = nb + XK_BYTES + ld * XV_PITCH + lh * 32; *(LAS u32x4*)vb = vr0; *(LAS u32x4*)(vb + 16) = vr1;
      }
      __syncthreads();
    }
    lsum += __shfl_xor(lsum, 32);
    const float linv = 1.0f / lsum;
    bf16_t* op = OC + qrow * DM + h * 256 + dh * 128 + 4 * hh;
#pragma unroll
    for (int dt = 0; dt < 4; ++dt)
#pragma unroll
      for (int g = 0; g < 4; ++g) {
        u32x2 w; w.x = pkbf(o[dt][4 * g] * linv, o[dt][4 * g + 1] * linv); w.y = pkbf(o[dt][4 * g + 2] * linv, o[dt][4 * g + 3] * linv);
        *(u32x2*)(op + dt * 32 + 8 * g) = w;
      }
  }
}

#define XB_TMO      128
#define XB_XCNT(j)  (256  + 64 * (j))
#define XB_XSUB(j)  (1280 + 64 * (j))
#define XB_XGEN(j)  (2304 + 64 * (j))
#define XB_TOP      3328
#define XB_TOPGEN   3392
#define XB_XSUB(j)  (1280 + 64 * (j))
#define XB_XGEN(j)  (2304 + 64 * (j))
#define XB_TOP      3328
#define XB_TOPGEN   3392
#define XCD_BAR_WORDS 3456
#define XB_SPIN_CAP (1u << 18)

DI unsigned xb_ld(unsigned* p)              { return __hip_atomic_load(p, __ATOMIC_RELAXED, __HIP_MEMORY_SCOPE_AGENT); }
DI unsigned xb_add(unsigned* p, unsigned v) { return __hip_atomic_fetch_add(p, v, __ATOMIC_RELAXED, __HIP_MEMORY_SCOPE_AGENT); }
DI unsigned xb_xcc_id() { return (unsigned)__builtin_amdgcn_s_getreg((3 << 11) | 20) & 0xFu; }
#define XB_SPIN(cond, bar) do { unsigned _sp = 0; while (cond) { __builtin_amdgcn_s_sleep(1); \
    if ((++_sp & 255u) == 0u) { if (xb_ld(&(bar)[XB_TMO])) break; if (_sp > XB_SPIN_CAP) { atomicAdd(&(bar)[XB_TMO], 1u); break; } } } } while (0)

struct XcdBarrier {
    unsigned* bar; unsigned x;
    volatile LAS unsigned* st;
};

DI XcdBarrier xcd_barrier_post(unsigned* bar, volatile LAS unsigned* st) {
    XcdBarrier b; b.bar = bar; b.x = xb_xcc_id(); b.st = st;
    if (threadIdx.x == 0) (void)xb_add(&bar[XB_XCNT(b.x)], 1u);
    return b;
}
DI void xcd_barrier_complete(unsigned* bar, unsigned x, unsigned& nloc, unsigned& nx) {
    const unsigned G = gridDim.x * gridDim.y * gridDim.z;
    unsigned sum, cnt, mine, sp = 0u;
    for (;;) {
        sum = 0u; cnt = 0u; mine = 0u;
#pragma unroll
        for (unsigned j = 0; j < 16; ++j) { const unsigned c = xb_ld(&bar[XB_XCNT(j)]); sum += c; cnt += (c > 0u) ? 1u : 0u; mine = (j == x) ? c : mine; }
        if (sum == G) break;
        __builtin_amdgcn_s_sleep(1);
        if ((++sp & 255u) == 0u) { if (xb_ld(&bar[XB_TMO])) break; if (sp > XB_SPIN_CAP) { atomicAdd(&bar[XB_TMO], 1u); break; } }
    }
    nloc = mine > 0u ? mine : 1u; nx = cnt > 0u ? cnt : 1u;
}

DI void xcd_barrier(const XcdBarrier& b) {
    asm volatile("s_waitcnt vmcnt(0)" ::: "memory");
    __syncthreads();
    if (threadIdx.x == 0) {
        unsigned* bar = b.bar;
        __builtin_amdgcn_s_waitcnt(0);
        unsigned nloc = b.st[0], nx = b.st[1];
        if (nloc == 0u) { xcd_barrier_complete(bar, b.x, nloc, nx); b.st[0] = nloc; b.st[1] = nx; }
        const unsigned old = xb_add(&bar[XB_XSUB(b.x)], 1u);
        const unsigned gen = old / nloc;
        if (old + 1u == (gen + 1u) * nloc) {
            __builtin_amdgcn_fence(__ATOMIC_RELEASE, "agent");
            asm volatile("s_waitcnt vmcnt(0)" ::: "memory");
            const unsigned og = xb_add(&bar[XB_TOP], 1u);
            const unsigned tg = og / nx;
            if (og + 1u == (tg + 1u) * nx) xb_add(&bar[XB_TOPGEN], 1u);
            else XB_SPIN(xb_ld(&bar[XB_TOPGEN]) == tg, bar);
            __builtin_amdgcn_fence(__ATOMIC_ACQUIRE, "agent");
            xb_add(&bar[XB_XGEN(b.x)], 1u);
            asm volatile("s_waitcnt vmcnt(0)" ::: "memory");
        } else {
            XB_SPIN(xb_ld(&bar[XB_XGEN(b.x)]) == gen, bar);
            __builtin_amdgcn_fence(__ATOMIC_ACQUIRE, "agent");
            asm volatile("s_waitcnt vmcnt(0)" ::: "memory");
        }
    }
    __syncthreads();
}

constexpr int LDS_BYTES = 131072 + 64;
constexpr int N_PHASES = 30;
constexpr int SCAN_BLOCKS = 192;
#ifndef HIDE_CONV
#define HIDE_CONV 1
#endif
constexpr int CONV_A = 16 * 176 + 44 * 32 + 16 * 88 + 16 * 64, CONV_ALL = 2 * 16 * 176 + 2 * 44 * 32 + 16 * 88 + 16 * 64 + 3 * 16 * 32;
#ifndef PH_MASK
#define PH_MASK 0xff
#endif
#define EN(k) (((PH_MASK) >> (k)) & 1)
#ifndef REPK
#define REPK -1
#endif
__global__ void __launch_bounds__(512, 2) mk_fwd(Params p) {
  extern __shared__ __attribute__((aligned(16))) unsigned char lds_raw[];
  LAS unsigned char* lds = (LAS unsigned char*)lds_raw;
  cg::grid_group grid = cg::this_grid();
  const int ph_lo = p.ph_lo, ph_hi = p.ph_hi;
  volatile LAS unsigned* bst = (volatile LAS unsigned*)(lds + 131072);
  if (threadIdx.x < 2) bst[threadIdx.x] = 0u;
  __syncthreads();
  XcdBarrier xbar = xcd_barrier_post((unsigned*)(p.ws + WS_BAR), bst);
  int rep = 0; unsigned nbar = 0;
#pragma unroll 1
  for (int ph = ph_lo; ph < ph_hi;) {
    KP kp = (KP)__builtin_amdgcn_kernarg_segment_ptr();
    asm volatile("" : "+s"(kp));
    int tid = threadIdx.x; asm volatile("" : "+v"(tid));
    int bid = blockIdx.x; asm volatile("" : "+s"(bid));
    int G = gridDim.x; asm volatile("" : "+s"(G));
    const int lane = tid & 63, wave = __builtin_amdgcn_readfirstlane(tid >> 6);
    const int gw = bid * 8 + wave, NGW = G * 8;
    unsigned char* ws = kp->ws; unsigned char* W = ws + WS_W;
    bf16_t* XB = (bf16_t*)(ws + WS_XB); float* SS = (float*)(ws + WS_SS); bf16_t* U = (bf16_t*)(ws + WS_U);
    const int l = ph >= 15 ? 1 : 0, s = ph - 15 * l;
    if (s == 6 || s == 7) { ++ph; continue; }
    if (EN(0) && s == 0) {
      phase_conv(kp, l, lds, gw, NGW, wave, lane, 0, CONV_ALL);
      if (l == 0) phase_init(kp, gw, NGW, lane, 0);
    } else if (EN(1) && (s == 1 || s == 13)) {
      pg8::Gemm g{XB, (const bf16_t*)(W + (s == 1 ? W_WI1 : W_WI2)), MTOK, 5632, 1024};
      pg8::StaticOrder S; S.init(MTOK, 5632, G, bid);
      EpiSwiGLU E{U, SS};
      pg8::gemm_phase<EpiSwiGLU, pg8::StaticOrder, true, true>(lds, g, S, E, tid);
    } else if (EN(2) && (s == 2 || s == 14 || s == 9 || s == 12)) {
      const bf16_t* A = (s == 9) ? (const bf16_t*)(ws + WS_Y) : (s == 12) ? (const bf16_t*)(ws + WS_U + (size_t)MTOK * DM * 2) : (const bf16_t*)U;
      const size_t wo = (s == 2) ? W_WO1 : (s == 14) ? W_WO2 : (s == 9) ? W_WOUT : W_WOX;
      pg8::Gemm g{A, (const bf16_t*)(W + wo), MTOK, 1024, (s == 2 || s == 14) ? 2816 : 1024};
      pg8::StaticOrder S; S.init(MTOK, 1024, G, bid);
      EpiResid E{kp->in[0], kp->out, XB, SS, (s == 2 || s == 14) ? 0.5f : 1.0f, ph == 2, ph == N_PHASES - 1};
      pg8::gemm_phase<EpiResid, pg8::StaticOrder, true, true>(lds, g, S, E, tid);
    } else if (EN(3) && (s == 3 || s == 10)) {
      pg8::Gemm g{XB, (const bf16_t*)(W + (s == 3 ? W_WIN : W_WQ)), MTOK, 1024, 1024};
      WinOrder S; S.init(s == 3 ? 2816 : 1024, G, bid, s == 3);
      EpiScaleBf16 E{U, s == 3 ? PW : DM, SS, (bf16_t*)(ws + WS_KVC), 2048, (const float*)(ws + WS_RSM)};
      pg8::gemm_phase<EpiScaleBf16, WinOrder, true, true>(lds, g, S, E, tid);
    } else if (EN(4) && (s == 4 || s == 6)) {
      phase_prep_rwkv(kp, l, 0, lds, tid, bid, G);
      if (s == 4 && rep == 0) { phase_attn_prep<0>(kp, l, lds, gw, NGW, wave, lane); if (G <= SCAN_BLOCKS) phase_attn_prep<1>(kp, l, lds, gw, NGW, wave, lane); }
    } else if (EN(5) && (s == 5 || s == 7)) {
      if (G > SCAN_BLOCKS && bid >= SCAN_BLOCKS) {
        phase_chunk(kp, l, lds, tid, (bid - SCAN_BLOCKS) * 8 + wave, (G - SCAN_BLOCKS) * 8, 0, 1536);
        __syncthreads();
        phase_attn_prep<1>(kp, l, lds, (bid - SCAN_BLOCKS) * 8 + wave, (G - SCAN_BLOCKS) * 8, wave, lane);
      }
      phase_scan(kp, 0, lds, tid, bid);
    } else if (EN(6) && s == 8) {
      if (G <= SCAN_BLOCKS) { phase_chunk(kp, l, lds, tid, gw, NGW, 0, 1536); __syncthreads(); }
      phase_attn(kp, l, lds, tid, gw, NGW, bid, G);
    } else if (EN(7) && s == 11) {
      phase_xattn(kp, lds, tid, bid, G);
    }
    if (REPK >= 0 && REPK < 9) {
      const int kind = (s == 0) ? 0 : (s == 1 || s == 13) ? 1 : (s == 3 || s == 10) ? 3 : (s == 4 || s == 6) ? 4 : (s == 5 || s == 7) ? 5 : (s == 8) ? 6 : (s == 11) ? 7 : 2;
      if (kind == REPK && rep == 0) { rep = 1; if (REPK == 2) xcd_barrier(xbar); __syncthreads(); continue; }
      rep = 0;
    }
    if (ph + 1 < ph_hi) {
      if (ph_hi > 1000) grid.sync();
      xcd_barrier(xbar); if (REPK == 9) xcd_barrier(xbar);
    }
    ++ph;
  }
}

extern "C" void kernel_launch(void* const* d_in, const int* in_sizes, int n_in, void* d_out, int out_size, void* d_ws, size_t ws_size, hipStream_t stream) {
  static int grid = 0;
  if (grid == 0) {
    if (n_in != 37 || out_size != MTOK * DM || ws_size < WS_END) { fprintf(stderr, "kernel_launch: unexpected shapes / workspace (n_in %d out %d ws %zu need %zu)\n", n_in, out_size, ws_size, (size_t)WS_END); grid = -1; return; }
    int dev = 0, cus = 0, per_cu = 0;
    (void)hipGetDevice(&dev);
    (void)hipDeviceGetAttribute(&cus, hipDeviceAttributeMultiprocessorCount, dev);
    (void)hipFuncSetAttribute((const void*)mk_fwd, hipFuncAttributeMaxDynamicSharedMemorySize, LDS_BYTES);
    (void)hipOccupancyMaxActiveBlocksPerMultiprocessor(&per_cu, (const void*)mk_fwd, 512, LDS_BYTES);
    if (per_cu < 1) { fprintf(stderr, "kernel_launch: occupancy query says %d blocks/CU\n", per_cu); per_cu = 1; }
    if (cus < SCAN_BLOCKS) { fprintf(stderr, "kernel_launch: this kernel needs >= %d CUs (found %d)\n", SCAN_BLOCKS, cus); grid = -1; return; }
    grid = cus;
    (void)hipGetLastError();
  }
  if (grid < 0) return;
  Params p{};
  for (int i = 0; i < 37; ++i) p.in[i] = (const float*)d_in[i];
  p.out = (float*)d_out; p.ws = (unsigned char*)d_ws;
  (void)hipMemsetAsync((unsigned char*)d_ws + WS_BAR, 0, 16384, stream);
#if MK_LAUNCHES == 1
  p.ph_lo = 0; p.ph_hi = N_PHASES;
  void* args[] = {&p};
  hipError_t e = hipLaunchCooperativeKernel((const void*)mk_fwd, dim3(grid), dim3(512), args, LDS_BYTES, stream);
  if (e != hipSuccess) fprintf(stderr, "cooperative launch failed: %s (grid %d)\n", hipGetErrorString(e), grid);
#else
  for (int ph = 0; ph < N_PHASES; ++ph) { p.ph_lo = ph; p.ph_hi = ph + 1; hipLaunchKernelGGL(mk_fwd, dim3(grid), dim3(512), LDS_BYTES, stream, p); }
#endif
}
```

```cpp
#include <hip/hip_runtime.h>
#include <hip/hip_cooperative_groups.h>
#include <cstdio>
#include <cstdint>
namespace cg = cooperative_groups;

#ifndef REPK
#define REPK -1
#endif
#ifndef MK_LAUNCHES
#define MK_LAUNCHES 1
#endif

namespace pg8 {
#define PG8_LAS __attribute__((address_space(3)))
typedef unsigned short bf16_t;
typedef short bf16x8 __attribute__((ext_vector_type(8)));
typedef float f32x4 __attribute__((ext_vector_type(4)));
typedef unsigned u32x4 __attribute__((ext_vector_type(4)));
constexpr int BM = 256, BK = 64, HALF = 128, HTB = HALF * BK * 2  , STAGE_BYTES = 8 * HTB, NXCD = 8, WGM = 8;

__host__ __device__ __forceinline__ int lds_byte(int r, int c) { const int st = (r >> 4) * 2 + (c >> 5), rr = r & 15, cc = c & 31, ob = rr * 64 + cc * 2; return st * 1024 + (ob ^ (((ob >> 9) & 1) << 5)); }
__host__ __device__ __forceinline__ void stage_rc(int b, int& R, int& C) { const int st = b / 1024, sb = b % 1024, swz = sb ^ (((sb >> 9) & 1) << 5); R = (st >> 1) * 16 + swz / 64; C = (st & 1) * 32 + (swz % 64) / 2; }
__host__ __device__ __forceinline__ int perm32(int rho) { const int n = rho >> 4, i = rho & 15; return 8 * (i >> 2) + 4 * n + (i & 3); }

struct Unit { int pm, pn; };
struct Gemm { const bf16_t* A; const bf16_t* Bt; int M, N, K; };

struct StaticOrder {
    int nM, nN, nwg, G, c;
    __host__ __device__ void init(int M, int N, int G_, int c_) { nM = M / BM; nN = N / BM; nwg = nM * nN; G = G_; c = c_; }
    __host__ __device__ bool next(int i, Unit& u) const {
        const long L = (long)i * G + c; if (L >= nwg) return false;
        int wgid = (int)L; { const int q = nwg / NXCD, r = nwg % NXCD, xcd = wgid % NXCD, off = wgid / NXCD; wgid = (xcd < r ? xcd * (q + 1) : r * (q + 1) + (xcd - r) * q) + off; }
        const int nig = WGM * nN, gid = wgid / nig, fm = gid * WGM, gsz = (nM - fm) < WGM ? (nM - fm) : WGM;
        u.pm = fm + ((wgid % nig) % gsz); u.pn = (wgid % nig) / gsz; return true;
    }
    __device__ __forceinline__ void a_ready(const Unit&) const {}
    __device__ __forceinline__ void done(const Unit&) const {}
};

template <class Epi, class Sched, bool ALIGN_EPI = false, bool SP2 = false>
__device__ __forceinline__ void gemm_phase(PG8_LAS unsigned char* lds, const Gemm g, const Sched& S, const Epi& E, const int tid) {
    const int wid = __builtin_amdgcn_readfirstlane(tid >> 6), lane = tid & 63, wr = wid >> 2, wc = wid & 3, fr = lane & 15, fq = lane >> 4;
    const int K = g.K, nt = K / BK;
    unsigned voffA[2], voffB[2];
#pragma unroll
    for (int i = 0; i < 2; ++i) { int R, C; stage_rc(tid * 16 + i * 8192, R, C); const int Rb = Epi::PERM ? ((R & ~31) + perm32(R & 31)) : R;
        voffA[i] = (unsigned)(R * K + C) * 2u; voffB[i] = (unsigned)(Rb * K + C) * 2u; }
    const size_t kstep = (size_t)(BK * 2);
    const size_t hstep = (size_t)HALF * K * 2;
    const size_t tstep = 2 * hstep;
    const unsigned ldsw = (unsigned)wid * 1024u;
    const int aoff = lds_byte(wr * 64 + fr, fq * 8), boff = lds_byte(wc * 32 + fr, fq * 8);
#define PG8_SA(b, h) (((b) * 2 + (h)) * HTB)
#define PG8_SB(b, h) ((4 + (b) * 2 + (h)) * HTB)
#define PG8_STAGE(bufoff, gbase, voff) do { _Pragma("unroll") for (int _i = 0; _i < 2; ++_i) \
        __builtin_amdgcn_global_load_lds((const unsigned*)((const char*)(gbase) + (voff)[_i]), (PG8_LAS unsigned*)(lds + (bufoff) + ldsw + _i * 8192), 16, 0, 0); } while (0)
#define PG8_LDA(dst, b, h) do { _Pragma("unroll") for (int m = 0; m < 4; ++m) _Pragma("unroll") for (int k = 0; k < 2; ++k) dst[m][k] = *(const PG8_LAS bf16x8*)(lds + PG8_SA(b, h) + aoff + m * 2048 + k * 1024); } while (0)
#define PG8_LDB(dst, b, h) do { _Pragma("unroll") for (int n = 0; n < 2; ++n) _Pragma("unroll") for (int k = 0; k < 2; ++k) dst[n][k] = *(const PG8_LAS bf16x8*)(lds + PG8_SB(b, h) + boff + n * 2048 + k * 1024); } while (0)
#define PG8_MMA(ai, bj, At, Bt) do { __builtin_amdgcn_s_setprio(1); _Pragma("unroll") for (int m = 0; m < 4; ++m) _Pragma("unroll") for (int n = 0; n < 2; ++n) _Pragma("unroll") for (int k = 0; k < 2; ++k) \
        acc[ai][bj][m][n] = __builtin_amdgcn_mfma_f32_16x16x32_bf16(Bt[n][k], At[m][k], acc[ai][bj][m][n], 0, 0, 0); __builtin_amdgcn_s_setprio(0); } while (0)
#define PG8_WAIT_V(n) asm volatile("s_waitcnt vmcnt(" #n ")" ::: "memory")
#define PG8_WAIT_L(n) asm volatile("s_waitcnt lgkmcnt(" #n ")" ::: "memory")
#define PG8_BAR __builtin_amdgcn_s_barrier()
#define PG8_SCHED __builtin_amdgcn_sched_barrier(0)
    Unit cur, nxt; int ui = 0;
    if (!S.next(0, cur)) return;
    f32x4 acc[2][2][4][2];
#pragma unroll
    for (int a = 0; a < 2; ++a)
#pragma unroll
        for (int b = 0; b < 2; ++b)
#pragma unroll
            for (int m = 0; m < 4; ++m)
#pragma unroll
                for (int n = 0; n < 2; ++n) acc[a][b][m][n] = (f32x4){0.f, 0.f, 0.f, 0.f};
    bf16x8 At[4][2], B0[2][2], B1[2][2];
    const char* cA = (const char*)g.A + (size_t)cur.pm * tstep; const char* cB = (const char*)g.Bt + (size_t)cur.pn * tstep;
    S.a_ready(cur);
    if constexpr (SP2) {
        PG8_STAGE(PG8_SB(0, 0), cB, voffB); PG8_STAGE(PG8_SB(0, 1), cB + hstep, voffB); PG8_STAGE(PG8_SA(0, 0), cA, voffA); PG8_STAGE(PG8_SA(0, 1), cA + hstep, voffA);
        if (wr == 1) PG8_BAR;
        PG8_WAIT_V(2); PG8_BAR;
        PG8_STAGE(PG8_SB(1, 0), cB + kstep, voffB); PG8_STAGE(PG8_SA(1, 0), cA + kstep, voffA); PG8_STAGE(PG8_SB(1, 1), cB + hstep + kstep, voffB);
        PG8_WAIT_V(6); PG8_BAR;
    } else {
        PG8_STAGE(PG8_SB(0, 0), cB, voffB); PG8_STAGE(PG8_SA(0, 0), cA, voffA); PG8_STAGE(PG8_SB(0, 1), cB + hstep, voffB); PG8_STAGE(PG8_SA(0, 1), cA + hstep, voffA);
        if (wr == 1) PG8_BAR;
        PG8_WAIT_V(4); PG8_BAR;
        PG8_STAGE(PG8_SB(1, 0), cB + kstep, voffB); PG8_STAGE(PG8_SA(1, 0), cA + kstep, voffA); PG8_STAGE(PG8_SB(1, 1), cB + hstep + kstep, voffB);
        PG8_WAIT_V(6); PG8_BAR;
    }
    for (;;) {
        const bool has_next = S.next(ui + 1, nxt);
        const char* nA = has_next ? (const char*)g.A + (size_t)nxt.pm * tstep : cA; const char* nB = has_next ? (const char*)g.Bt + (size_t)nxt.pn * tstep : cB;
        for (int t = 0; t < nt; t += 2) {
            const bool last = (t == nt - 2);
            const char* a1 = cA + (size_t)(t + 1) * kstep;
            const char* a2 = last ? nA : cA + (size_t)(t + 2) * kstep; const char* b2 = last ? nB : cB + (size_t)(t + 2) * kstep;
            const char* a3 = a2 + kstep; const char* b3 = b2 + kstep;
            if (last && has_next) S.a_ready(nxt);
            if constexpr (SP2) {
            PG8_LDB(B0, 0, 0); PG8_LDB(B1, 0, 1); PG8_SCHED; PG8_LDA(At, 0, 0); PG8_STAGE(PG8_SA(1, 1), a1 + hstep, voffA);
            PG8_WAIT_V(8); PG8_WAIT_L(0); PG8_BAR; PG8_MMA(0, 0, At, B0); PG8_MMA(0, 1, At, B1); PG8_BAR; PG8_SCHED;
            PG8_LDA(At, 0, 1); PG8_STAGE(PG8_SB(0, 0), b2, voffB); PG8_STAGE(PG8_SB(0, 1), b2 + hstep, voffB); PG8_STAGE(PG8_SA(0, 0), a2, voffA);
            PG8_WAIT_V(8); PG8_WAIT_L(0); PG8_BAR; PG8_MMA(1, 0, At, B0); PG8_MMA(1, 1, At, B1); PG8_BAR; PG8_SCHED;
            PG8_LDB(B0, 1, 0); PG8_LDB(B1, 1, 1); PG8_SCHED; PG8_LDA(At, 1, 0); PG8_STAGE(PG8_SA(0, 1), a2 + hstep, voffA);
            PG8_WAIT_V(8); PG8_WAIT_L(0); PG8_BAR; PG8_MMA(0, 0, At, B0); PG8_MMA(0, 1, At, B1); PG8_BAR; PG8_SCHED;
            PG8_LDA(At, 1, 1); PG8_STAGE(PG8_SB(1, 0), b3, voffB); PG8_STAGE(PG8_SB(1, 1), b3 + hstep, voffB); PG8_STAGE(PG8_SA(1, 0), a3, voffA);
            PG8_WAIT_V(8); PG8_WAIT_L(0); PG8_BAR; PG8_MMA(1, 0, At, B0); PG8_MMA(1, 1, At, B1); PG8_BAR; PG8_SCHED;
            } else {
            PG8_LDB(B0, 0, 0); PG8_SCHED; PG8_LDA(At, 0, 0); PG8_STAGE(PG8_SA(1, 1), a1 + hstep, voffA);
            PG8_WAIT_L(8); PG8_BAR; PG8_WAIT_L(0); PG8_MMA(0, 0, At, B0); PG8_BAR; PG8_SCHED;
            PG8_LDB(B1, 0, 1); PG8_STAGE(PG8_SB(0, 0), b2, voffB);
            PG8_BAR; PG8_WAIT_L(0); PG8_MMA(0, 1, At, B1); PG8_BAR;
            PG8_LDA(At, 0, 1); PG8_STAGE(PG8_SA(0, 0), a2, voffA);
            PG8_BAR; PG8_WAIT_L(0); PG8_MMA(1, 0, At, B0); PG8_BAR; PG8_SCHED;
            PG8_STAGE(PG8_SB(0, 1), b2 + hstep, voffB);
            PG8_WAIT_V(6); PG8_BAR; PG8_MMA(1, 1, At, B1); PG8_BAR;
            PG8_LDB(B0, 1, 0); PG8_SCHED; PG8_LDA(At, 1, 0); PG8_STAGE(PG8_SA(0, 1), a2 + hstep, voffA);
            PG8_WAIT_L(8); PG8_BAR; PG8_WAIT_L(0); PG8_MMA(0, 0, At, B0); PG8_BAR; PG8_SCHED;
            PG8_LDB(B1, 1, 1); PG8_STAGE(PG8_SB(1, 0), b3, voffB);
            PG8_BAR; PG8_WAIT_L(0); PG8_MMA(0, 1, At, B1); PG8_BAR;
            PG8_LDA(At, 1, 1); PG8_STAGE(PG8_SA(1, 0), a3, voffA);
            PG8_BAR; PG8_WAIT_L(0); PG8_MMA(1, 0, At, B0); PG8_BAR; PG8_SCHED;
            PG8_STAGE(PG8_SB(1, 1), b3 + hstep, voffB);
            PG8_WAIT_V(6); PG8_BAR; PG8_MMA(1, 1, At, B1); PG8_BAR;
            }
        }
        if constexpr (ALIGN_EPI) { if (wr == 0) PG8_BAR; }
        if constexpr (!Epi::AFTER_DRAIN) { E(acc, cur, wr, wc, fr, fq); S.done(cur); }
        if (!has_next) break;
#pragma unroll
        for (int a = 0; a < 2; ++a)
#pragma unroll
            for (int b = 0; b < 2; ++b)
#pragma unroll
                for (int m = 0; m < 4; ++m)
#pragma unroll
                    for (int n = 0; n < 2; ++n) acc[a][b][m][n] = (f32x4){0.f, 0.f, 0.f, 0.f};
        cur = nxt; cA = nA; cB = nB; ++ui;
        if constexpr (ALIGN_EPI) { if (wr == 1) PG8_BAR; }
    }
    PG8_WAIT_V(0);
    if constexpr (!ALIGN_EPI) { if (wr == 0) PG8_BAR; }
    PG8_BAR;
    if constexpr (Epi::AFTER_DRAIN) { E.fused(acc, cur, wr, wc, fr, fq, lds, wid, lane); S.done(cur); }
#undef PG8_SA
#undef PG8_SB
#undef PG8_STAGE
#undef PG8_LDA
#undef PG8_LDB
#undef PG8_MMA
#undef PG8_WAIT_V
#undef PG8_WAIT_L
#undef PG8_BAR
#undef PG8_SCHED
}
}

#define LAS __attribute__((address_space(3)))
typedef unsigned short bf16_t;
typedef short bf16x8 __attribute__((ext_vector_type(8)));
typedef short s16x4 __attribute__((ext_vector_type(4)));
typedef float f32x4 __attribute__((ext_vector_type(4)));
typedef float f32x2 __attribute__((ext_vector_type(2)));
typedef float f32x16 __attribute__((ext_vector_type(16)));
typedef unsigned u32x4 __attribute__((ext_vector_type(4)));
typedef unsigned u32x2 __attribute__((ext_vector_type(2)));
typedef _Float16 h4_t __attribute__((ext_vector_type(4)));
typedef _Float16 h8_t __attribute__((ext_vector_type(8)));
typedef __bf16 bfv2_t __attribute__((ext_vector_type(2)));
#define DI __device__ __forceinline__

DI unsigned pkbf(float a, float b) { bfv2_t v = __builtin_convertvector((f32x2){a, b}, bfv2_t); return __builtin_bit_cast(unsigned, v); }
DI float bf2f(unsigned short u) { return __uint_as_float(((unsigned)u) << 16); }
DI float bflo(unsigned u) { return __uint_as_float(u << 16); }
DI float bfhi(unsigned u) { return __uint_as_float(u & 0xffff0000u); }
DI float wave_sum(float v) {
#pragma unroll
  for (int o = 1; o < 64; o <<= 1) v += __shfl_xor(v, o);
  return v;
}
DI float vfma(float a, float b, float c) { float d; asm("v_fma_f32 %0, %1, %2, %3" : "=v"(d) : "v"(a), "v"(b), "v"(c)); return d; }
DI float sigmoidf_(float x) { return __builtin_amdgcn_rcpf(1.0f + __expf(-x)); }
#define LDS_WAIT() asm volatile("s_waitcnt lgkmcnt(0)" ::: "memory")
template <int CTRL> DI float dpp_addx(float x) { return x + __builtin_bit_cast(float, __builtin_amdgcn_update_dpp(0, __builtin_bit_cast(int, x), CTRL, 0xf, 0xf, true)); }
DI float allreduce16(float x) { x = dpp_addx<0xB1>(x); x = dpp_addx<0x4E>(x); x = dpp_addx<0x141>(x); x = dpp_addx<0x140>(x); return x; }
DI float rdlane(float x, int l) { return __builtin_bit_cast(float, __builtin_amdgcn_readlane(__builtin_bit_cast(int, x), l)); }
DI float wave_sum_dpp(float x) { x = allreduce16(x); return (rdlane(x, 0) + rdlane(x, 16)) + (rdlane(x, 32) + rdlane(x, 48)); }


constexpr int MTOK = 16384, DM = 1024, TSEQ = 2048, NB = 8, DFF = 2816, PW = 2816  , NMEM = 256;
constexpr int AW = 384, APROJ = 1280;
constexpr int PQ = 1280, PK = 1664, PV = 2048, PC = 2432;
constexpr int THALF = 1024;
constexpr float RMS_EPS = 1e-6f;

constexpr size_t SZ_WI = (size_t)5632 * 1024 * 2, SZ_WO = (size_t)1024 * 2816 * 2, SZ_WIN = (size_t)2816 * 1024 * 2, SZ_WKV = (size_t)2048 * 1024 * 2, SZ_SQ = (size_t)1024 * 1024 * 2;
constexpr size_t W_WI1 = 0, W_WO1 = W_WI1 + SZ_WI, W_WIN = W_WO1 + SZ_WO, W_WKV = W_WIN + SZ_WIN, W_WOUT = W_WKV + SZ_WKV, W_WQ = W_WOUT + SZ_SQ, W_WOX = W_WQ + SZ_SQ,
                 W_WI2 = W_WOX + SZ_SQ, W_WO2 = W_WI2 + SZ_WI, W_END = W_WO2 + SZ_WO;
constexpr size_t WS_W = 0;
constexpr size_t WS_XB = WS_W + W_END;
constexpr size_t WS_MEMB = WS_XB + (size_t)MTOK * DM * 2;
constexpr size_t WS_U = WS_MEMB + (size_t)2048 * DM * 2;
constexpr size_t WS_R2 = WS_U + (size_t)MTOK * PW * 2;
constexpr size_t WS_VF = WS_R2 + (size_t)48 * THALF * 384 * 2;
constexpr size_t WS_KNC = WS_VF + (size_t)MTOK * AW * 2;
constexpr size_t WS_VTC = WS_KNC + (size_t)2048 * 1024 * 2;
constexpr size_t WS_KVC = WS_VTC + (size_t)2048 * 1024 * 2;
constexpr size_t WS_VTB = WS_KVC + (size_t)2048 * 2048 * 2;
constexpr size_t WS_SS = WS_VTB + (size_t)MTOK * AW * 2;
constexpr size_t WS_RKB = WS_SS + (size_t)MTOK * 16 * 4;
constexpr size_t WS_RSM = WS_RKB + (size_t)48 * 2048 * 4;
constexpr size_t WS_ST = WS_RSM + 2048 * 4;
constexpr size_t WS_BAR = WS_ST + (size_t)48 * 4096 * 4;
constexpr size_t WS_S6X = WS_BAR + 16384;
constexpr size_t S6_BH_BYTES = (size_t)TSEQ * 768;
constexpr size_t WS_END = WS_S6X + 8 * S6_BH_BYTES;
constexpr size_t WS_S6 = WS_XB;
constexpr size_t WS_Y = WS_R2;
constexpr size_t WS_YH = WS_W + W_WI1;
constexpr size_t WS_BON = WS_YH + (size_t)MTOK * AW * 2;
static_assert((size_t)48 * THALF * 384 * 2 == (size_t)(MTOK + 2048) * DM * 2, "S6 half must fit [xb | memb] exactly");
static_assert(2 * (size_t)MTOK * AW * 2 <= W_WOUT, "y + bonus must fit the dead weight prefix");

struct Params { const float* in[37]; float* out; unsigned char* ws; int ph_lo, ph_hi; };
typedef const Params __attribute__((address_space(4)))* KP;
DI unsigned char* s6_block(KP p, int bh) { return bh < 40 ? (unsigned char*)p->out + (size_t)bh * S6_BH_BYTES : p->ws + WS_S6X + (size_t)(bh - 40) * S6_BH_BYTES; }

DI float row_rstd16(const float* ss, int row) {
  const f32x4* p = (const f32x4*)(ss + (size_t)row * 16);
  f32x4 a = p[0], b = p[1], c = p[2], d = p[3];
  float s = ((a[0] + a[1]) + (a[2] + a[3])) + ((b[0] + b[1]) + (b[2] + b[3])) + ((c[0] + c[1]) + (c[2] + c[3])) + ((d[0] + d[1]) + (d[2] + d[3]));
  return __builtin_amdgcn_rsqf(s * (1.0f / 1024.0f) + RMS_EPS);
}
struct EpiScaleBf16 {
  static constexpr bool PERM = true, AFTER_DRAIN = false;
  bf16_t* O1; int ldc1; const float* ss; bf16_t* O2; int ldc2; const float* rs2;
  DI void operator()(const f32x4 (&acc)[2][2][4][2], const pg8::Unit& u, int wr, int wc, int fr, int fq) const {
    const bool kv = u.pm >= 64;
    bf16_t* base = kv ? O2 : O1; const int ldc = kv ? ldc2 : ldc1;
    const int row0 = (kv ? (u.pm - 64) : u.pm) * 256 + wr * 64 + fr, col0 = (kv ? (u.pn - 11) : u.pn) * 256 + wc * 32 + 8 * fq;
#pragma unroll
    for (int ai = 0; ai < 2; ++ai)
#pragma unroll
      for (int m = 0; m < 4; ++m) {
        const int row = row0 + ai * 128 + m * 16;
        const float rs = kv ? rs2[row] : row_rstd16(ss, row);
        bf16_t* rowp = base + (size_t)row * ldc + col0;
#pragma unroll
        for (int bj = 0; bj < 2; ++bj) {
          const f32x4 v0 = acc[ai][bj][m][0] * rs, v1 = acc[ai][bj][m][1] * rs;
          u32x4 w; w.x = pkbf(v0[0], v0[1]); w.y = pkbf(v0[2], v0[3]); w.z = pkbf(v1[0], v1[1]); w.w = pkbf(v1[2], v1[3]);
          *(u32x4*)(rowp + bj * 128) = w;
        }
      }
  }
};
struct EpiSwiGLU {
  static constexpr bool PERM = true, AFTER_DRAIN = false;
  bf16_t* O; const float* ss;
  DI void operator()(const f32x4 (&acc)[2][2][4][2], const pg8::Unit& u, int wr, int wc, int fr, int fq) const {
    const int row0 = u.pm * 256 + wr * 64 + fr, col0 = u.pn * 128 + wc * 32 + 8 * fq;
#pragma unroll
    for (int ai = 0; ai < 2; ++ai)
#pragma unroll
      for (int m = 0; m < 4; ++m) {
        const int row = row0 + ai * 128 + m * 16;
        const float rs = row_rstd16(ss, row);
        float o[8];
#pragma unroll
        for (int n = 0; n < 2; ++n)
#pragma unroll
          for (int j = 0; j < 4; ++j) { const float g = acc[ai][0][m][n][j] * rs, up = acc[ai][1][m][n][j] * rs; o[n * 4 + j] = g * up * __builtin_amdgcn_rcpf(1.0f + __expf(-g)); }
        u32x4 w; w.x = pkbf(o[0], o[1]); w.y = pkbf(o[2], o[3]); w.z = pkbf(o[4], o[5]); w.w = pkbf(o[6], o[7]);
        *(u32x4*)(O + (size_t)row * DFF + col0) = w;
      }
  }
};
struct EpiResid {
  static constexpr bool PERM = true, AFTER_DRAIN = false;
  const float* Xin32; float* Xout32; bf16_t* XB; float* ss; float scale; int first, last;
  DI void operator()(const f32x4 (&acc)[2][2][4][2], const pg8::Unit& u, int wr, int wc, int fr, int fq) const {
    const int row0 = u.pm * 256 + wr * 64 + fr, col0 = u.pn * 256 + wc * 32 + 8 * fq;
#pragma unroll
    for (int ai = 0; ai < 2; ++ai)
#pragma unroll
      for (int m = 0; m < 4; ++m) {
        const int row = row0 + ai * 128 + m * 16; const size_t off = (size_t)row * DM + col0;
        float sq = 0.f;
#pragma unroll
        for (int bj = 0; bj < 2; ++bj) {
          const size_t o = off + bj * 128;
          f32x4 x0, x1;
          if (first) { x0 = *(const f32x4*)(Xin32 + o); x1 = *(const f32x4*)(Xin32 + o + 4); }
          else { const u32x4 ub = *(const u32x4*)(XB + o); x0[0] = bflo(ub.x); x0[1] = bfhi(ub.x); x0[2] = bflo(ub.y); x0[3] = bfhi(ub.y); x1[0] = bflo(ub.z); x1[1] = bfhi(ub.z); x1[2] = bflo(ub.w); x1[3] = bfhi(ub.w); }
          const f32x4 n0 = x0 + acc[ai][bj][m][0] * scale, n1 = x1 + acc[ai][bj][m][1] * scale;
          if (last) { *(f32x4*)(Xout32 + o) = n0; *(f32x4*)(Xout32 + o + 4) = n1; }
          else { u32x4 w; w.x = pkbf(n0[0], n0[1]); w.y = pkbf(n0[2], n0[3]); w.z = pkbf(n1[0], n1[1]); w.w = pkbf(n1[2], n1[3]); *(u32x4*)(XB + o) = w; }
          sq += ((n0[0] * n0[0] + n0[1] * n0[1]) + (n0[2] * n0[2] + n0[3] * n0[3])) + ((n1[0] * n1[0] + n1[1] * n1[1]) + (n1[2] * n1[2] + n1[3] * n1[3]));
        }
        sq += __shfl_xor(sq, 16); sq += __shfl_xor(sq, 32);
        if (fq == 0 && !last) ss[(size_t)row * 16 + u.pn * 4 + wc] = sq;
      }
  }
};
struct WinOrder {
  pg8::StaticOrder so; int G, c, nkv;
  DI void init(int N_, int G_, int c_, int with_kv) { so.init(MTOK, N_, G_, c_); G = G_; c = c_; nkv = with_kv ? 64 : 0; }
  DI bool next(int i, pg8::Unit& u) const {
    const long L = (long)i * G + c;
    if (L < so.nwg) return so.next(i, u);
    const int j = (int)(L - so.nwg); if (j >= nkv) return false;
    u.pm = 64 + (j >> 3); u.pn = 11 + (j & 7); return true;
  }
  DI void a_ready(const pg8::Unit&) const {}
  DI void done(const pg8::Unit&) const {}
};

struct ConvDesc { const float* W; const float* g; bf16_t* WT; int K, Nsrc, mode, nvalid, item, nblk; };
DI void conv_load(const ConvDesc& d, int lane, f32x4 (&v)[8], float (&gv)[8]) {
  const int kb = d.item / d.nblk, nb = d.item % d.nblk, k0 = 64 * kb, n0 = 32 * nb;
  int sc = n0;
  if (d.mode == 1) { const int pn = n0 >> 8, c = n0 & 255; sc = (c < 128) ? (128 * pn + c) : (2816 + 128 * pn + (c - 128)); }
  const bool valid = n0 < d.nvalid;
  const int kr = lane >> 3, n4 = (lane & 7) * 4;
#pragma unroll
  for (int i = 0; i < 8; ++i) {
    const int kk = 8 * i + kr;
    v[i] = valid ? *(const f32x4*)(d.W + (size_t)(k0 + kk) * d.Nsrc + sc + n4) : (f32x4){0.f, 0.f, 0.f, 0.f};
    gv[i] = d.g ? d.g[k0 + kk] : 1.0f;
  }
}
DI void conv_finish(const ConvDesc& d, const f32x4 (&v)[8], const float (&gv)[8], LAS float* scr, int lane) {
  const int kb = d.item / d.nblk, nb = d.item % d.nblk, k0 = 64 * kb, n0 = 32 * nb;
  const int kr = lane >> 3, n4 = (lane & 7) * 4;
#pragma unroll
  for (int i = 0; i < 8; ++i) {
    const int kk = 8 * i + kr; LAS float* dd = scr + kk * 33 + n4;
    dd[0] = v[i][0] * gv[i]; dd[1] = v[i][1] * gv[i]; dd[2] = v[i][2] * gv[i]; dd[3] = v[i][3] * gv[i];
  }
  LDS_WAIT();
  const int c = lane & 7;
#pragma unroll
  for (int j = 0; j < 4; ++j) {
    const int n = (lane >> 3) + 8 * j; const LAS float* s = scr + (8 * c) * 33 + n;
    u32x4 o; o.x = pkbf(s[0 * 33], s[1 * 33]); o.y = pkbf(s[2 * 33], s[3 * 33]); o.z = pkbf(s[4 * 33], s[5 * 33]); o.w = pkbf(s[6 * 33], s[7 * 33]);
    *(u32x4*)(d.WT + (size_t)(n0 + n) * d.K + k0 + 8 * c) = o;
  }
  LDS_WAIT();
}
DI ConvDesc conv_desc(KP p, int l, int it) {
  unsigned char* W = p->ws + WS_W;
  constexpr int I_WI = 16 * 176, I_WO = 44 * 32, I_WIN = 16 * 88, I_WKV = 16 * 64, I_SQ = 16 * 32;
  int r = it;
  if (r < I_WI) return ConvDesc{p->in[3] + (size_t)l * 1024 * 5632, p->in[2] + l * 1024, (bf16_t*)(W + W_WI1), 1024, 5632, 1, 5632, r, 176}; r -= I_WI;
  if (r < I_WO) return ConvDesc{p->in[4] + (size_t)l * 2816 * 1024, nullptr, (bf16_t*)(W + W_WO1), 2816, 1024, 0, 1024, r, 32}; r -= I_WO;
  if (r < I_WIN) return ConvDesc{p->in[6] + (size_t)l * 1024 * 2688, p->in[5] + l * 1024, (bf16_t*)(W + W_WIN), 1024, 2688, 0, 2688, r, 88}; r -= I_WIN;
  if (r < I_WKV) return ConvDesc{p->in[30] + (size_t)l * 1024 * 2048, p->in[28] + l * 1024, (bf16_t*)(W + W_WKV), 1024, 2048, 0, 2048, r, 64}; r -= I_WKV;
  if (r < I_SQ) return ConvDesc{p->in[7] + (size_t)l * 1024 * 1024, nullptr, (bf16_t*)(W + W_WOUT), 1024, 1024, 0, 1024, r, 32}; r -= I_SQ;
  if (r < I_SQ) return ConvDesc{p->in[29] + (size_t)l * 1024 * 1024, p->in[27] + l * 1024, (bf16_t*)(W + W_WQ), 1024, 1024, 0, 1024, r, 32}; r -= I_SQ;
  if (r < I_SQ) return ConvDesc{p->in[31] + (size_t)l * 1024 * 1024, nullptr, (bf16_t*)(W + W_WOX), 1024, 1024, 0, 1024, r, 32}; r -= I_SQ;
  if (r < I_WI) return ConvDesc{p->in[35] + (size_t)l * 1024 * 5632, p->in[34] + l * 1024, (bf16_t*)(W + W_WI2), 1024, 5632, 1, 5632, r, 176}; r -= I_WI;
  return ConvDesc{p->in[36] + (size_t)l * 2816 * 1024, nullptr, (bf16_t*)(W + W_WO2), 2816, 1024, 0, 1024, r, 32};
}
DI void phase_conv(KP p, int l, LAS unsigned char* lds, int gw, int NGW, int wave, int lane, int it_lo, int it_hi) {
  LAS float* scr = (LAS float*)(lds + wave * 8448);
  int it = it_lo + gw;
  if (it >= it_hi) return;
  ConvDesc cur = conv_desc(p, l, it);
  f32x4 v[8]; float gv[8];
  conv_load(cur, lane, v, gv);
  for (; it < it_hi; it += NGW) {
    const bool more = it + NGW < it_hi;
    ConvDesc nxt = cur; f32x4 v2[8]; float gv2[8];
    if (more) { nxt = conv_desc(p, l, it + NGW); conv_load(nxt, lane, v2, gv2); }
    __builtin_amdgcn_sched_barrier(0);
    conv_finish(cur, v, gv, scr, lane);
    if (more) { cur = nxt;
#pragma unroll
      for (int i = 0; i < 8; ++i) { v[i] = v2[i]; gv[i] = gv2[i]; } }
  }
}
DI void phase_init(KP p, int gw, int NGW, int lane, int row_lo) {
  bf16_t* XB = (bf16_t*)(p->ws + WS_XB); float* SS = (float*)(p->ws + WS_SS); float* RSM = (float*)(p->ws + WS_RSM);
  auto row_src = [&](int m) { return m < MTOK ? p->in[0] + (size_t)m * DM : p->in[1] + (size_t)(m - MTOK) * DM; };
  f32x4 nx[4];
  { const int m0 = row_lo + gw; if (m0 < MTOK + 2048) {
#pragma unroll
      for (int j = 0; j < 4; ++j) nx[j] = ((const f32x4*)row_src(m0))[lane + 64 * j]; } }
  for (int m = row_lo + gw; m < MTOK + 2048; m += NGW) {
    const bool isx = m < MTOK;
    f32x4 v[4]; float s = 0.f;
#pragma unroll
    for (int j = 0; j < 4; ++j) v[j] = nx[j];
    { const int mn = (m + NGW < MTOK + 2048) ? m + NGW : m;
#pragma unroll
      for (int j = 0; j < 4; ++j) nx[j] = ((const f32x4*)row_src(mn))[lane + 64 * j]; }
    __builtin_amdgcn_sched_barrier(0);
#pragma unroll
    for (int j = 0; j < 4; ++j) s += (v[j][0] * v[j][0] + v[j][1] * v[j][1]) + (v[j][2] * v[j][2] + v[j][3] * v[j][3]);
    s = wave_sum(s);
    u32x2* o8 = (u32x2*)(XB + (size_t)m * DM);
#pragma unroll
    for (int j = 0; j < 4; ++j) { u32x2 w; w.x = pkbf(v[j][0], v[j][1]); w.y = pkbf(v[j][2], v[j][3]); o8[lane + 64 * j] = w; }
    if (isx) {
      if (lane < 16) SS[(size_t)m * 16 + lane] = lane == 0 ? s : 0.f;
    } else if (lane == 0) RSM[m - MTOK] = __builtin_amdgcn_rsqf(s * (1.0f / 1024.0f) + RMS_EPS);
  }
}

DI void unpack8(const u32x4 u, float (&f)[8]) { f[0] = bflo(u.x); f[1] = bfhi(u.x); f[2] = bflo(u.y); f[3] = bfhi(u.y); f[4] = bflo(u.z); f[5] = bfhi(u.z); f[6] = bflo(u.w); f[7] = bfhi(u.w); }
DI void phase_prep_rwkv(KP p, int l, int hf, LAS unsigned char* lds, int tid, int bid, int G) {
  LAS float* ps = (LAS float*)lds;
  LAS float* vd = ps + 16 * 1280;
  LAS unsigned short* twb = (LAS unsigned short*)(vd + 16 * 32);
  LAS unsigned short* adb = twb + 16 * 40;
  LAS unsigned short* vdb = adb + 16 * 40;
  LAS _Float16* vdT = (LAS _Float16*)(vdb + 16 * 40);
  const bf16_t* P = (const bf16_t*)(p->ws + WS_U);
  _Float16* VF = (_Float16*)(p->ws + WS_VF); float* RKB = (float*)(p->ws + WS_RKB);
  const float* mu = p->in[8] + l * APROJ; const float* w0 = p->in[9] + l * AW; const float* w_up = p->in[10] + l * 32 * AW;
  const float* a0 = p->in[11] + l * AW; const float* a_up = p->in[12] + l * 32 * AW;
  const float* k_k = p->in[14] + l * AW; const float* k_a = p->in[15] + l * AW; const float* r_k = p->in[16] + l * AW;
  const float* v0 = p->in[19]; const float* v_down = p->in[20]; const float* v_up = p->in[21];
  const int lane = tid & 63, wv = tid >> 6, l15 = lane & 15, q4 = lane >> 4, hd = wv < 6 ? wv : 5;
  bf16x8 wf[4], af[4], vf[4]; float w0c[4], a0c[4], v0c[4], kkc[4], kac[4], rkc[4];
#pragma unroll
  for (int dt = 0; dt < 4; ++dt) {
    const int c = hd * 64 + dt * 16 + l15;
    const float* wp = w_up + (size_t)(8 * q4) * AW + c; const float* ap = a_up + (size_t)(8 * q4) * AW + c; const float* vp_ = v_up + (size_t)(8 * q4) * AW + c;
    u32x4 w; w.x = pkbf(wp[0], wp[AW]); w.y = pkbf(wp[2 * AW], wp[3 * AW]); w.z = pkbf(wp[4 * AW], wp[5 * AW]); w.w = pkbf(wp[6 * AW], wp[7 * AW]); wf[dt] = __builtin_bit_cast(bf16x8, w);
    u32x4 x; x.x = pkbf(ap[0], ap[AW]); x.y = pkbf(ap[2 * AW], ap[3 * AW]); x.z = pkbf(ap[4 * AW], ap[5 * AW]); x.w = pkbf(ap[6 * AW], ap[7 * AW]); af[dt] = __builtin_bit_cast(bf16x8, x);
    u32x4 y = (u32x4){0u, 0u, 0u, 0u};
    if (l == 1) { y.x = pkbf(vp_[0], vp_[AW]); y.y = pkbf(vp_[2 * AW], vp_[3 * AW]); y.z = pkbf(vp_[4 * AW], vp_[5 * AW]); y.w = pkbf(vp_[6 * AW], vp_[7 * AW]); }
    vf[dt] = __builtin_bit_cast(bf16x8, y);
    w0c[dt] = w0[c]; a0c[dt] = a0[c]; v0c[dt] = (l == 1) ? v0[c] : 0.f; kkc[dt] = k_k[c]; kac[dt] = k_a[c]; rkc[dt] = r_k[c];
  }
  if (l == 1) { for (int e = tid; e < 384 * 32; e += 512) { const int cc = e >> 5, j = e & 31; vdT[j * 392 + cc] = (_Float16)v_down[e]; } }
  for (int tile = bid; tile < 1024; tile += G) {
    const int b = tile >> 7, t0 = (tile & 127) * 16, tok0 = b * TSEQ + t0;
    _Float16* S6 = (_Float16*)s6_block(p, b * 6 + hd);
    for (int e = tid; e < 2560; e += 512) {
      const int i = e / 160, c8 = (e % 160) * 8;
      const size_t r = (size_t)(tok0 + i) * PW + c8;
      const u32x4 cur = *(const u32x4*)(P + r);
      u32x4 prv = (u32x4){0u, 0u, 0u, 0u};
      if (t0 + i > 0) prv = *(const u32x4*)(P + r - PW);
      float pc[8], pp[8]; unpack8(cur, pc); unpack8(prv, pp);
      const f32x4 m0 = *(const f32x4*)(mu + c8), m1 = *(const f32x4*)(mu + c8 + 4);
      f32x4 o0, o1;
#pragma unroll
      for (int j = 0; j < 4; ++j) { o0[j] = pc[j] + m0[j] * (pp[j] - pc[j]); o1[j] = pc[4 + j] + m1[j] * (pp[4 + j] - pc[4 + j]); }
      *(LAS f32x4*)(ps + i * 1280 + c8) = o0; *(LAS f32x4*)(ps + i * 1280 + c8 + 4) = o1;
    }
    _Float16 vfv[16];
#pragma unroll
    for (int i = 0; i < 4; ++i)
#pragma unroll
      for (int dt = 0; dt < 4; ++dt) vfv[i * 4 + dt] = (l == 1) ? VF[(size_t)(tok0 + 4 * q4 + i) * AW + hd * 64 + dt * 16 + l15] : (_Float16)0.f;
    __syncthreads();
    {
      const int i = tid >> 5, j = tid & 31;
      { const float xv = ps[i * 1280 + 1152 + j]; twb[i * 40 + j] = (unsigned short)(pkbf(1.0f - 2.0f * __builtin_amdgcn_rcpf(1.0f + __expf(2.0f * xv)), 0.f) & 0xffffu); }
      adb[i * 40 + j] = (unsigned short)(pkbf(ps[i * 1280 + 1184 + j], 0.f) & 0xffffu);
      if (l == 1) {
        float s0 = 0.f, s1 = 0.f;
#pragma unroll 4
        for (int cc = 0; cc < 384; cc += 8) {
          const f32x4 pa = *(const LAS f32x4*)(ps + i * 1280 + 768 + cc), pb = *(const LAS f32x4*)(ps + i * 1280 + 768 + cc + 4);
          const h8_t hv = *(const LAS h8_t*)(vdT + j * 392 + cc);
          s0 += (pa[0] * (float)hv[0] + pa[1] * (float)hv[1]) + (pa[2] * (float)hv[2] + pa[3] * (float)hv[3]);
          s1 += (pb[0] * (float)hv[4] + pb[1] * (float)hv[5]) + (pb[2] * (float)hv[6] + pb[3] * (float)hv[7]);
        }
        vdb[i * 40 + j] = (unsigned short)(pkbf(s0 + s1, 0.f) & 0xffffu);
      }
    }
    __syncthreads();
    if (wv < 6) {
      const bf16x8 atw = *(const LAS bf16x8*)(twb + l15 * 40 + 8 * q4), aad = *(const LAS bf16x8*)(adb + l15 * 40 + 8 * q4);
      bf16x8 avd = atw; if (l == 1) avd = *(const LAS bf16x8*)(vdb + l15 * 40 + 8 * q4);
      f32x4 accw[4], acca[4], accv[4];
#pragma unroll
      for (int dt = 0; dt < 4; ++dt) {
        const f32x4 z4 = (f32x4){0.f, 0.f, 0.f, 0.f};
        accw[dt] = __builtin_amdgcn_mfma_f32_16x16x32_bf16(atw, wf[dt], z4, 0, 0, 0);
        acca[dt] = __builtin_amdgcn_mfma_f32_16x16x32_bf16(aad, af[dt], z4, 0, 0, 0);
        accv[dt] = z4; if (l == 1) accv[dt] = __builtin_amdgcn_mfma_f32_16x16x32_bf16(avd, vf[dt], z4, 0, 0, 0);
      }
#pragma unroll
      for (int i = 0; i < 4; ++i) {
        const int ti = 4 * q4 + i, tok = tok0 + ti, t = t0 + ti;
        float kkr[4], kp[4], rr[4], vp[4], aa4[4], om4[4]; float nsum = 0.f, rksum = 0.f;
#pragma unroll
        for (int dt = 0; dt < 4; ++dt) {
          const int c = hd * 64 + dt * 16 + l15;
          const float aw = w0c[dt] + accw[dt][i], aa = a0c[dt] + acca[dt][i], av = v0c[dt] + accv[dt][i];
          const float z = -aw; const float sp = fmaxf(z, 0.f) + __logf(1.0f + __expf(-fabsf(z)));
          const float e = __expf(-sp - 0.5f), xm = -e;
          float om = 1.0f / 40320.0f; om = om * xm + 1.0f / 5040.0f; om = om * xm + 1.0f / 720.0f; om = om * xm + 1.0f / 120.0f; om = om * xm + 1.0f / 24.0f; om = om * xm + 1.0f / 6.0f; om = om * xm + 0.5f; om = om * xm + 1.0f; om = om * xm;
          const float a = sigmoidf_(aa);
          const float r = ps[ti * 1280 + c], k = ps[ti * 1280 + 384 + c], v = ps[ti * 1280 + 768 + c];
          float vpp = v;
          if (l == 0) VF[(size_t)tok * AW + c] = (_Float16)v;
          else { const float vfl = (float)vfv[i * 4 + dt]; vpp = v + (vfl - v) * sigmoidf_(av); }
          kkr[dt] = k * kkc[dt]; nsum += kkr[dt] * kkr[dt];
          kp[dt] = k * (1.0f + (a - 1.0f) * kac[dt]); rksum += r * kp[dt] * rkc[dt];
          rr[dt] = r; vp[dt] = vpp; aa4[dt] = a; om4[dt] = om;
        }
        nsum = allreduce16(nsum); rksum = allreduce16(rksum);
        const float inv = __builtin_amdgcn_rcpf(fmaxf(__builtin_amdgcn_sqrtf(nsum), 1e-12f));
        const size_t base = ((size_t)t * 6) * 64 + l15;
#pragma unroll
        for (int dt = 0; dt < 4; ++dt) {
          const float kk = kkr[dt] * inv; const size_t o = base + dt * 16;
          S6[o] = (_Float16)rr[dt]; S6[o + 64] = (_Float16)kp[dt]; S6[o + 128] = (_Float16)vp[dt]; S6[o + 192] = (_Float16)kk; S6[o + 256] = (_Float16)(-(kk * aa4[dt])); S6[o + 320] = (_Float16)om4[dt];
        }
        if (l15 == 0) RKB[(size_t)(b * 6 + hd) * TSEQ + t] = rksum;
      }
    }
    __syncthreads();
  }
}

DI void transpose64(const bf16_t* src, size_t spitch, bf16_t* dst, size_t dpitch, LAS unsigned short* scr, int lane) {
#pragma unroll
  for (int it = 0; it < 8; ++it) {
    const int row = it * 8 + (lane >> 3), c8 = (lane & 7) * 8;
    const u32x4 v = *(const u32x4*)(src + (size_t)row * spitch + c8);
    LAS unsigned* d = (LAS unsigned*)(scr + row * 66 + c8);
    d[0] = v.x; d[1] = v.y; d[2] = v.z; d[3] = v.w;
  }
  LDS_WAIT();
#pragma unroll
  for (int t8 = 0; t8 < 8; ++t8) {
    unsigned w[4];
#pragma unroll
    for (int j = 0; j < 4; ++j) { const unsigned lo = scr[(t8 * 8 + 2 * j) * 66 + lane], hi = scr[(t8 * 8 + 2 * j + 1) * 66 + lane]; w[j] = lo | (hi << 16); }
    u32x4 o; o.x = w[0]; o.y = w[1]; o.z = w[2]; o.w = w[3];
    *(u32x4*)(dst + (size_t)lane * dpitch + t8 * 8) = o;
  }
  LDS_WAIT();
}
template <int PART> DI void phase_attn_prep(KP p, int l, LAS unsigned char* lds, int gw, int NGW, int wave, int lane) {
  bf16_t* P = (bf16_t*)(p->ws + WS_U);
  LAS unsigned short* scr = (LAS unsigned short*)(lds + wave * 8448);
  if constexpr (PART == 0) {
    const float* qg = p->in[22] + l * 64; const float* kg = p->in[23] + l * 64;
    const int cl = lane < 48 ? lane : 47, d0 = (cl & 7) * 8;
    float gg[8];
#pragma unroll
    for (int j = 0; j < 8; ++j) gg[j] = qg[d0 + j] * kg[d0 + j];
    for (int tok0 = gw; tok0 < MTOK; tok0 += 8 * NGW) {
      u32x4 rows[8];
#pragma unroll
      for (int q = 0; q < 8; ++q) { const int tok = tok0 + q * NGW; rows[q] = (tok < MTOK) ? *(const u32x4*)(P + (size_t)tok * PW + PK + cl * 8) : (u32x4){0u, 0u, 0u, 0u}; }
#pragma unroll
      for (int q = 0; q < 8; ++q) {
        const int tok = tok0 + q * NGW;
        float f[8]; unpack8(rows[q], f);
        float s = 0.f;
#pragma unroll
        for (int j = 0; j < 8; ++j) s += f[j] * f[j];
        s += __shfl_xor(s, 1); s += __shfl_xor(s, 2); s += __shfl_xor(s, 4);
        const float rs = __builtin_amdgcn_rsqf(s * (1.0f / 64.0f) + RMS_EPS);
        u32x4 o; o.x = pkbf(f[0] * rs * gg[0], f[1] * rs * gg[1]); o.y = pkbf(f[2] * rs * gg[2], f[3] * rs * gg[3]); o.z = pkbf(f[4] * rs * gg[4], f[5] * rs * gg[5]); o.w = pkbf(f[6] * rs * gg[6], f[7] * rs * gg[7]);
        if (lane < 48 && tok < MTOK) *(u32x4*)(P + (size_t)tok * PW + PK + cl * 8) = o;
      }
    }
  }
  if constexpr (PART == 0) {
    bf16_t* VTB = (bf16_t*)(p->ws + WS_VTB);
    for (int it = gw; it < 8 * 6 * 32; it += NGW) {
      const int tb = it & 31, h = (it >> 5) % 6, b = it / 192;
      transpose64(P + (size_t)(b * TSEQ + tb * 64) * PW + PV + h * 64, PW, VTB + (size_t)((b * 6 + h) * 64) * TSEQ + tb * 64, TSEQ, scr, lane);
    }
  }
  if constexpr (PART == 1) {
    const bf16_t* KVC = (const bf16_t*)(p->ws + WS_KVC); bf16_t* KNC = (bf16_t*)(p->ws + WS_KNC); bf16_t* VTC = (bf16_t*)(p->ws + WS_VTC);
    const float* qg = p->in[32] + l * 256; const float* kg = p->in[33] + l * 256;
    for (int it = gw; it < 2048 * 4; it += NGW) {
      const int row = it >> 2, h = it & 3;
      const u32x2 u = *(const u32x2*)(KVC + (size_t)row * 2048 + h * 256 + lane * 4);
      const float f0 = bflo(u.x), f1 = bfhi(u.x), f2 = bflo(u.y), f3 = bfhi(u.y);
      const float s = wave_sum((f0 * f0 + f1 * f1) + (f2 * f2 + f3 * f3));
      const float rs = __builtin_amdgcn_rsqf(s * (1.0f / 256.0f) + RMS_EPS);
      const f32x4 a = *(const f32x4*)(qg + lane * 4), bb = *(const f32x4*)(kg + lane * 4);
      u32x2 o; o.x = pkbf(f0 * rs * a[0] * bb[0], f1 * rs * a[1] * bb[1]); o.y = pkbf(f2 * rs * a[2] * bb[2], f3 * rs * a[3] * bb[3]);
      *(u32x2*)(KNC + (size_t)row * 1024 + h * 256 + lane * 4) = o;
    }
    for (int it = gw; it < 8 * 4 * 16; it += NGW) {
      const int mt = it & 3, dt = (it >> 2) & 3, h = (it >> 4) & 3, b = it >> 6;
      transpose64(KVC + (size_t)(b * 256 + mt * 64) * 2048 + 1024 + h * 256 + dt * 64, 2048, VTC + (size_t)((b * 4 + h) * 256 + dt * 64) * 256 + mt * 64, 256, scr, lane);
    }
  }
}

constexpr int SCAN_STEP_B = 1152, SCAN_CHUNK_B = 32 * SCAN_STEP_B;
DI void scan_issue(const unsigned char* src, int lt, u32x4 (&v)[6]) {
#pragma unroll
  for (int q = 0; q < 6; ++q) v[q] = *(const u32x4*)(src + (size_t)(q * 256 + lt) * 16);
}
DI void scan_write(const u32x4 (&v)[6], LAS unsigned char* dst, int lt) {
#pragma unroll
  for (int q = 0; q < 6; ++q) {
    const int e = (q * 256 + lt) * 8, t = e / 384, rem = e - t * 384, X = rem >> 6, c = rem & 63;
    LAS unsigned char* d = dst + t * SCAN_STEP_B;
    if (X == 1 || X == 4 || X == 5) {
      const h8_t hv = __builtin_bit_cast(h8_t, v[q]);
      f32x4 a, b; a[0] = (float)hv[0]; a[1] = (float)hv[1]; a[2] = (float)hv[2]; a[3] = (float)hv[3]; b[0] = (float)hv[4]; b[1] = (float)hv[5]; b[2] = (float)hv[6]; b[3] = (float)hv[7];
      LAS unsigned char* dd = d + (X == 1 ? 0 : X == 4 ? 256 : 512) + c * 4;
      *(LAS f32x4*)dd = a; *(LAS f32x4*)(dd + 16) = b;
    } else {
      *(LAS u32x4*)(d + (X == 0 ? 768 : X == 3 ? 896 : 1024) + c * 2) = v[q];
    }
  }
}
DI void phase_scan(KP p, int hf, LAS unsigned char* lds, int tid, int bid) {
  if (bid >= 192) return;
  const int bh = bid >> 2, rg = bid & 3, b = bh / 6, h = bh % 6;
  const int wave = tid >> 6, lane = tid & 63;
  LAS unsigned char* buf = lds;
  const unsigned char* S6 = s6_block(p, bh);
  const float* RKB = (const float*)(p->ws + WS_RKB) + (size_t)bh * TSEQ;
  _Float16* YH = (_Float16*)(p->ws + WS_YH); _Float16* BON = (_Float16*)(p->ws + WS_BON);
  bool is_comp = wave < 4; int widx = wave & 3;
  {
    LAS int* roles = (LAS int*)(lds + 2 * SCAN_CHUNK_B);
    const int simd = (int)__builtin_amdgcn_s_getreg((1 << 11) | (4 << 6) | 4);
    if (lane == 0) roles[wave] = simd;
    __syncthreads();
    int sid[8], rk[8], nfirst = 0;
#pragma unroll
    for (int w = 0; w < 8; ++w) sid[w] = roles[w];
#pragma unroll
    for (int w = 0; w < 8; ++w) { int r = 0;
#pragma unroll
      for (int u = 0; u < 8; ++u) if (u < w && sid[u] == sid[w]) ++r;
      rk[w] = r; nfirst += (r == 0); }
    if (nfirst == 4) {
      int myr = 0, ci = 0, li = 0;
#pragma unroll
      for (int w = 0; w < 8; ++w) { if (w == wave) myr = rk[w]; if (w < wave) { ci += (rk[w] == 0); li += (rk[w] != 0); } }
      is_comp = (myr == 0); widx = is_comp ? ci : li;
    }
    __syncthreads();
  }
  const int kq = lane & 15, v = 16 * rg + 4 * widx + (lane >> 4);
  f32x2 S01 = {0.f, 0.f}, S23 = {0.f, 0.f};
  const int lt = widx * 64 + lane;
  u32x4 R[6]; unsigned bvv = 0u; float brk = 0.f;
  const int bt = lt >> 3, br2 = (lt & 7) * 2;
  if (!is_comp) {
    scan_issue(S6, lt, R); scan_write(R, buf, lt); scan_issue(S6 + 24576, lt, R);
    bvv = *(const unsigned*)(S6 + ((size_t)(bt * 6 + 2) * 64 + 16 * rg + br2) * 2); brk = RKB[bt];
  }

  __syncthreads();
  const size_t obase = (size_t)(b * TSEQ) * AW + h * 64;
  h4_t rp4 = {(_Float16)0.f, (_Float16)0.f, (_Float16)0.f, (_Float16)0.f}; float ykeep = 0.f;
  for (int ch = 0; ch < 64; ++ch) {
    if (!is_comp) {
      if (ch + 1 < 64) scan_write(R, buf + ((ch + 1) & 1) * SCAN_CHUNK_B, lt);
      if (ch + 2 < 64) scan_issue(S6 + (size_t)(ch + 2) * 24576, lt, R);
      {
        const h4_t hv = __builtin_bit_cast(h4_t, (u32x2){bvv, 0u});
        typedef _Float16 h2_t __attribute__((ext_vector_type(2)));
        h2_t o; o[0] = (_Float16)(brk * (float)hv[0]); o[1] = (_Float16)(brk * (float)hv[1]);
        *(h2_t*)(BON + obase + (size_t)(ch * 32 + bt) * AW + 16 * rg + br2) = o;
        if (ch + 1 < 64) { bvv = *(const unsigned*)(S6 + (size_t)(ch + 1) * 24576 + ((size_t)(bt * 6 + 2) * 64 + 16 * rg + br2) * 2); brk = RKB[(ch + 1) * 32 + bt]; }
      }
    } else {
      const LAS unsigned char* cb = buf + (ch & 1) * SCAN_CHUNK_B;
      f32x4 k4 = *(const LAS f32x4*)(cb + kq * 16), nb4 = *(const LAS f32x4*)(cb + 256 + kq * 16), nom4 = *(const LAS f32x4*)(cb + 512 + kq * 16);
      h4_t r4 = *(const LAS h4_t*)(cb + 768 + kq * 8), kk4 = *(const LAS h4_t*)(cb + 896 + kq * 8);
      _Float16 vh = *(const LAS _Float16*)(cb + 1024 + v * 2);
      f32x4 k4n = *(const LAS f32x4*)(cb + SCAN_STEP_B + kq * 16), nb4n = *(const LAS f32x4*)(cb + SCAN_STEP_B + 256 + kq * 16), nom4n = *(const LAS f32x4*)(cb + SCAN_STEP_B + 512 + kq * 16);
      h4_t r4n = *(const LAS h4_t*)(cb + SCAN_STEP_B + 768 + kq * 8), kk4n = *(const LAS h4_t*)(cb + SCAN_STEP_B + 896 + kq * 8);
      _Float16 vhn = *(const LAS _Float16*)(cb + SCAN_STEP_B + 1024 + v * 2);
#pragma unroll 8
      for (int s = 0; s < 32; ++s) {
        const LAS unsigned char* sb = cb + (s + 2 < 32 ? s + 2 : 31) * SCAN_STEP_B;
        const f32x4 k4m = *(const LAS f32x4*)(sb + kq * 16), nb4m = *(const LAS f32x4*)(sb + 256 + kq * 16), nom4m = *(const LAS f32x4*)(sb + 512 + kq * 16);
        const h4_t r4m = *(const LAS h4_t*)(sb + 768 + kq * 8), kk4m = *(const LAS h4_t*)(sb + 896 + kq * 8);
        const _Float16 vhm = *(const LAS _Float16*)(sb + 1024 + v * 2);
        __builtin_amdgcn_sched_barrier(0);
        const float vv = (float)vh;
        float sa = __builtin_fmaf(S01[0], (float)kk4[0], 0.f), y = __builtin_fmaf(S01[0], (float)rp4[0], 0.f);
        sa = __builtin_fmaf(S01[1], (float)kk4[1], sa); y = __builtin_fmaf(S01[1], (float)rp4[1], y);
        sa = __builtin_fmaf(S23[0], (float)kk4[2], sa); y = __builtin_fmaf(S23[0], (float)rp4[2], y);
        sa = __builtin_fmaf(S23[1], (float)kk4[3], sa); y = __builtin_fmaf(S23[1], (float)rp4[3], y);
        float t0 = vfma(vv, k4[0], S01[0]), t1 = vfma(vv, k4[1], S01[1]), t2 = vfma(vv, k4[2], S23[0]), t3 = vfma(vv, k4[3], S23[1]);
        sa = dpp_addx<0xB1>(sa); y = dpp_addx<0xB1>(y); sa = dpp_addx<0x4E>(sa); y = dpp_addx<0x4E>(y);
        sa = dpp_addx<0x141>(sa); y = dpp_addx<0x141>(y); sa = dpp_addx<0x140>(sa); y = dpp_addx<0x140>(y);
        t0 = vfma(sa, nb4[0], t0); t1 = vfma(sa, nb4[1], t1); t2 = vfma(sa, nb4[2], t2); t3 = vfma(sa, nb4[3], t3);
        S01[0] = vfma(nom4[0], S01[0], t0); S01[1] = vfma(nom4[1], S01[1], t1); S23[0] = vfma(nom4[2], S23[0], t2); S23[1] = vfma(nom4[3], S23[1], t3);
        ykeep = (kq == ((s + 15) & 15)) ? y : ykeep;
        if ((s & 15) == 0 && (ch | s) != 0) YH[obase + (size_t)(ch * 32 + s - 16 + kq) * AW + v] = (_Float16)ykeep;
        rp4 = r4; k4 = k4n; nb4 = nb4n; nom4 = nom4n; r4 = r4n; kk4 = kk4n; vh = vhn;
        k4n = k4m; nb4n = nb4m; nom4n = nom4m; r4n = r4m; kk4n = kk4m; vhn = vhm;
        __builtin_amdgcn_sched_barrier(0);
      }
    }
    asm volatile("s_waitcnt lgkmcnt(0)" ::: "memory"); __builtin_amdgcn_s_barrier(); asm volatile("" ::: "memory");
  }
  if (is_comp) {
    float y = S01[0] * (float)rp4[0]; y = __builtin_fmaf(S01[1], (float)rp4[1], y); y = __builtin_fmaf(S23[0], (float)rp4[2], y); y = __builtin_fmaf(S23[1], (float)rp4[3], y);
    y = allreduce16(y);
    ykeep = (kq == 15) ? y : ykeep;
    YH[obase + (size_t)(TSEQ - 16 + kq) * AW + v] = (_Float16)ykeep;
  }

}

#define MFMA32(a, b, c) __builtin_amdgcn_mfma_f32_32x32x16_bf16((a), (b), (c), 0, 0, 0)
constexpr float LOG2E = 1.4426950408889634f;
DI int crow(int r, int hi) { return (r & 3) + 8 * (r >> 2) + 4 * hi; }
DI bf16x8 pack8(const f32x16& x, int s) {
  u32x4 pk; pk.x = pkbf(x[8 * s], x[8 * s + 1]); pk.y = pkbf(x[8 * s + 2], x[8 * s + 3]); pk.z = pkbf(x[8 * s + 4], x[8 * s + 5]); pk.w = pkbf(x[8 * s + 6], x[8 * s + 7]);
  return __builtin_bit_cast(bf16x8, pk);
}
DI bf16x8 ld2x4(const bf16_t* p0) {
  const u32x2 a = *(const u32x2*)p0, b = *(const u32x2*)(p0 + 8);
  u32x4 r; r.x = a.x; r.y = a.y; r.z = b.x; r.w = b.y; return __builtin_bit_cast(bf16x8, r);
}
DI float sumsq8(const bf16x8 v) { const u32x4 u = __builtin_bit_cast(u32x4, v); float f[8]; unpack8(u, f); float s = 0.f;
#pragma unroll
  for (int j = 0; j < 8; ++j) s += f[j] * f[j];
  return s; }
DI void chunk_attn_task(const bf16_t* P, const bf16_t* VTB, bf16_t* Y, const LAS float* biasl, int task, int lane) {
  const int n = task & 31, bhh = task >> 5, h = bhh % 6, b = bhh / 6;
  const int c = lane & 31, hh = lane >> 5;
  bf16x8 qb[2][4]; float sc[2], m[2], lsum[2]; f32x16 o0[2], o1[2];
#pragma unroll
  for (int qh = 0; qh < 2; ++qh) {
    const int qpos = n * 64 + qh * 32 + c;
    const bf16_t* qp = P + (size_t)(b * TSEQ + qpos) * PW + PQ + h * 64 + 8 * hh;
    float sq = 0.f;
#pragma unroll
    for (int s = 0; s < 4; ++s) { qb[qh][s] = *(const bf16x8*)(qp + 16 * s); sq += sumsq8(qb[qh][s]); }
    sq += __shfl_xor(sq, 32);
    sc[qh] = __builtin_amdgcn_rsqf(sq * (1.0f / 64.0f) + RMS_EPS) * 0.125f * LOG2E;
    m[qh] = -1e30f; lsum[qh] = 0.f;
#pragma unroll
    for (int i = 0; i < 16; ++i) { o0[qh][i] = 0.f; o1[qh][i] = 0.f; }
  }
  const int kt0 = (n > 8 ? n - 8 : 0) * 2, kt1 = (n + 1) * 2;
  const bf16_t* Kb = P + (size_t)(b * TSEQ + c) * PW + PK + h * 64 + 8 * hh;
  const bf16_t* Vt = VTB + ((size_t)(b * 6 + h) * 64 + c) * TSEQ + 4 * hh;
  const LAS float* bias = biasl + h * 320;
  bf16x8 ka[4], va[2][2];
#pragma unroll
  for (int s = 0; s < 4; ++s) ka[s] = *(const bf16x8*)(Kb + (size_t)(kt0 * 32) * PW + 16 * s);
#pragma unroll
  for (int dt = 0; dt < 2; ++dt)
#pragma unroll
    for (int s2 = 0; s2 < 2; ++s2) va[dt][s2] = ld2x4(Vt + (size_t)dt * 32 * TSEQ + kt0 * 32 + 16 * s2);
#pragma unroll 1
  for (int kt = kt0; kt < kt1; ++kt) {
    const int key0 = kt * 32, keyn = (kt + 1 < kt1 ? kt + 1 : kt) * 32;
    bf16x8 kan[4], van[2][2];
#pragma unroll
    for (int s = 0; s < 4; ++s) kan[s] = *(const bf16x8*)(Kb + (size_t)keyn * PW + 16 * s);
#pragma unroll
    for (int dt = 0; dt < 2; ++dt)
#pragma unroll
      for (int s2 = 0; s2 < 2; ++s2) van[dt][s2] = ld2x4(Vt + (size_t)dt * 32 * TSEQ + keyn + 16 * s2);
    __builtin_amdgcn_sched_barrier(0);
#pragma unroll
    for (int qh = 0; qh < 2; ++qh) {
      const int qpos = n * 64 + qh * 32 + c;
      f32x16 st;
#pragma unroll
      for (int i = 0; i < 16; ++i) st[i] = 0.f;
#pragma unroll
      for (int s = 0; s < 4; ++s) st = MFMA32(ka[s], qb[qh][s], st);
      float tmax = -1e30f;
      const int qlo = n * 64 + qh * 32;
      if (qlo - (key0 + 31) >= 256) {
        const float bc = bias[319];
#pragma unroll
        for (int i = 0; i < 16; ++i) { st[i] = __builtin_fmaf(st[i], sc[qh], bc); tmax = fmaxf(tmax, st[i]); }
      } else if (qlo + 31 - key0 <= 256) {
        const LAS float* bp = bias + (qpos - key0 - 4 * hh + 63);
#pragma unroll
        for (int i = 0; i < 16; ++i) { st[i] = __builtin_fmaf(st[i], sc[qh], bp[-((i & 3) + 8 * (i >> 2))]); tmax = fmaxf(tmax, st[i]); }
      } else {
#pragma unroll
        for (int i = 0; i < 16; ++i) {
          const int rel = qpos - (key0 + crow(i, hh)); const int idx = (rel > 256 ? 256 : rel) + 63;
          st[i] = __builtin_fmaf(st[i], sc[qh], bias[idx]); tmax = fmaxf(tmax, st[i]);
        }
      }
      tmax = fmaxf(tmax, __shfl_xor(tmax, 32));
      const float mn = fmaxf(m[qh], tmax), alpha = __builtin_amdgcn_exp2f(m[qh] - mn); m[qh] = mn;
      float psum = 0.f;
#pragma unroll
      for (int i = 0; i < 16; ++i) { st[i] = __builtin_amdgcn_exp2f(st[i] - mn); psum += st[i]; }
      lsum[qh] = lsum[qh] * alpha + psum;
      if (__builtin_amdgcn_ballot_w64(alpha != 1.0f) != 0ull) {
#pragma unroll
        for (int i = 0; i < 16; ++i) { o0[qh][i] *= alpha; o1[qh][i] *= alpha; } }
      const bf16x8 p0 = pack8(st, 0), p1 = pack8(st, 1);
      o0[qh] = MFMA32(va[0][0], p0, o0[qh]); o0[qh] = MFMA32(va[0][1], p1, o0[qh]);
      o1[qh] = MFMA32(va[1][0], p0, o1[qh]); o1[qh] = MFMA32(va[1][1], p1, o1[qh]);
    }
#pragma unroll
    for (int s = 0; s < 4; ++s) ka[s] = kan[s];
    va[0][0] = van[0][0]; va[0][1] = van[0][1]; va[1][0] = van[1][0]; va[1][1] = van[1][1];
  }
#pragma unroll
  for (int qh = 0; qh < 2; ++qh) {
    const int qpos = n * 64 + qh * 32 + c;
    float ls = lsum[qh]; ls += __shfl_xor(ls, 32);
    const float linv = __builtin_amdgcn_rcpf(ls);
    bf16_t* yp = Y + (size_t)(b * TSEQ + qpos) * DM + 384 + h * 64 + 4 * hh;
#pragma unroll
    for (int g = 0; g < 4; ++g) {
      u32x2 w; w.x = pkbf(o0[qh][4 * g] * linv, o0[qh][4 * g + 1] * linv); w.y = pkbf(o0[qh][4 * g + 2] * linv, o0[qh][4 * g + 3] * linv); *(u32x2*)(yp + 8 * g) = w;
      u32x2 w1; w1.x = pkbf(o1[qh][4 * g] * linv, o1[qh][4 * g + 1] * linv); w1.y = pkbf(o1[qh][4 * g + 2] * linv, o1[qh][4 * g + 3] * linv); *(u32x2*)(yp + 32 + 8 * g) = w1;
    }
  }
}
DI void phase_chunk(KP p, int l, LAS unsigned char* lds, int tid, int gw, int NGW, int lo, int hi) {
  const int lane = tid & 63;
  const bf16_t* P = (const bf16_t*)(p->ws + WS_U); bf16_t* Y = (bf16_t*)(p->ws + WS_Y);
  LAS float* biasl = (LAS float*)lds;
  for (int i = tid; i < 6 * 320; i += 512) biasl[i] = p->in[24][l * 1920 + i] * LOG2E;
  __syncthreads();
  for (int it = lo + gw; it < hi; it += NGW) {
    const int bhh = it % 48, n = 31 - (it / 48);
    chunk_attn_task(P, (const bf16_t*)(p->ws + WS_VTB), Y, biasl, bhh * 32 + n, lane);
  }
}
DI void phase_attn(KP p, int l, LAS unsigned char* lds, int tid, int gw, int NGW, int bid, int G) {
  const int lane = tid & 63;
  const bf16_t* P = (const bf16_t*)(p->ws + WS_U); bf16_t* Y = (bf16_t*)(p->ws + WS_Y);
  LAS float* biasl = (LAS float*)lds;
  LAS float* pl = (LAS float*)(lds + 8192);
  LAS float* ub = (LAS float*)(lds + 8192 + 16384);
  for (int i = tid; i < 6 * 320; i += 512) biasl[i] = p->in[24][l * 1920 + i] * LOG2E;
  __syncthreads();
  {
    const float* pw = p->in[25] + (size_t)l * 4 * 64 * 64; const float* pscale = p->in[26] + l * 256;
    LAS unsigned short* plb = (LAS unsigned short*)pl;
    const int pwv = tid >> 6, pg = pwv & 3, pl15 = lane & 15, pq4 = lane >> 4;
    bf16x8 pf[2][2]; float psc[2];
#pragma unroll
    for (int dd = 0; dd < 2; ++dd) {
      const int dcol = ((pwv >> 2) * 2 + dd) * 16 + pl15;
      psc[dd] = pscale[pg * 64 + dcol];
#pragma unroll
      for (int s2 = 0; s2 < 2; ++s2) {
        const float* wp = pw + (size_t)pg * 4096 + (size_t)(32 * s2 + 8 * pq4) * 64 + dcol;
        u32x4 w; w.x = pkbf(wp[0], wp[64]); w.y = pkbf(wp[128], wp[192]); w.z = pkbf(wp[256], wp[320]); w.w = pkbf(wp[384], wp[448]);
        pf[dd][s2] = __builtin_bit_cast(bf16x8, w);
      }
    }
    u32x4 pr0 = (u32x4){0u, 0u, 0u, 0u}, pr1 = (u32x4){0u, 0u, 0u, 0u};
    auto pool_fetch = [&](int tile, u32x4& r0, u32x4& r1) {
      const int tok0 = tile * 16, t0 = tok0 & (TSEQ - 1);
      { const int e = tid, rr = e >> 5, c8 = (e & 31) * 8, dt = rr - 15; r0 = (u32x4){0u, 0u, 0u, 0u}; if (t0 + dt >= 0) r0 = *(const u32x4*)(P + (size_t)(tok0 + dt) * PW + PC + c8); }
      { const int e = tid + 512, rr = e >> 5, c8 = (e & 31) * 8, dt = rr - 15; r1 = (u32x4){0u, 0u, 0u, 0u}; if (e < 31 * 32 && t0 + dt >= 0) r1 = *(const u32x4*)(P + (size_t)(tok0 + dt) * PW + PC + c8); }
    };
    if (bid < 1024) pool_fetch(bid, pr0, pr1);
    for (int r2 = 0; r2 < (REPK == 62 ? 2 : 1); ++r2)
    for (int tile = bid; tile < 1024; tile += G) {
      const int tok0 = tile * 16, t0 = tok0 & (TSEQ - 1);
      { float f[8]; unpack8(pr0, f); const int e = tid, rr = e >> 5, c8 = (e & 31) * 8;
        f32x4 a, b2; a[0] = f[0]; a[1] = f[1]; a[2] = f[2]; a[3] = f[3]; b2[0] = f[4]; b2[1] = f[5]; b2[2] = f[6]; b2[3] = f[7];
        *(LAS f32x4*)(ub + rr * 256 + c8) = a; *(LAS f32x4*)(ub + rr * 256 + c8 + 4) = b2; }
      if (tid + 512 < 31 * 32) { float f[8]; unpack8(pr1, f); const int e = tid + 512, rr = e >> 5, c8 = (e & 31) * 8;
        f32x4 a, b2; a[0] = f[0]; a[1] = f[1]; a[2] = f[2]; a[3] = f[3]; b2[0] = f[4]; b2[1] = f[5]; b2[2] = f[6]; b2[3] = f[7];
        *(LAS f32x4*)(ub + rr * 256 + c8) = a; *(LAS f32x4*)(ub + rr * 256 + c8 + 4) = b2; }
      __syncthreads();
      { const int nt = (tile + G < 1024) ? tile + G : tile; pool_fetch(nt, pr0, pr1); }
      __builtin_amdgcn_sched_barrier(0);
#pragma unroll
      for (int k = 0; k < 8; ++k) {
        const int e = tid + 512 * k, i = e >> 8, c = e & 255, g = c >> 6, win = 2 << g;
        const int t = t0 + i, cnt = (t + 1 < win) ? t + 1 : win;
        float s = 0.f;
        for (int jj = 0; jj < win; ++jj) s += ub[(i + 15 - jj) * 256 + c];
        plb[i * 264 + c] = (unsigned short)(pkbf(s * __builtin_amdgcn_rcpf((float)cnt) - ub[(i + 15) * 256 + c], 0.f) & 0xffffu);
      }
      __syncthreads();
      {
        const bf16x8 a0 = *(const LAS bf16x8*)(plb + pl15 * 264 + pg * 64 + 8 * pq4), a1 = *(const LAS bf16x8*)(plb + pl15 * 264 + pg * 64 + 32 + 8 * pq4);
#pragma unroll
        for (int dd = 0; dd < 2; ++dd) {
          f32x4 acc = (f32x4){0.f, 0.f, 0.f, 0.f};
          acc = __builtin_amdgcn_mfma_f32_16x16x32_bf16(a0, pf[dd][0], acc, 0, 0, 0);
          acc = __builtin_amdgcn_mfma_f32_16x16x32_bf16(a1, pf[dd][1], acc, 0, 0, 0);
          const int dcol = ((pwv >> 2) * 2 + dd) * 16 + pl15;
#pragma unroll
          for (int i = 0; i < 4; ++i) Y[(size_t)(tok0 + 4 * pq4 + i) * DM + 768 + pg * 64 + dcol] = (bf16_t)(pkbf(acc[i] * psc[dd], 0.f) & 0xffffu);
        }
      }
      __syncthreads();
    }
  }
  {
    const _Float16* YH = (const _Float16*)(p->ws + WS_YH); const _Float16* BON = (const _Float16*)(p->ws + WS_BON);
    const float* mu = p->in[8] + l * APROJ; const float* g_up = p->in[13] + (size_t)l * 64 * AW; const float* gn_g = p->in[17] + l * AW; const float* gn_b = p->in[18] + l * AW;
    LAS unsigned short* sgb = (LAS unsigned short*)(lds + 8192);
    const int wv = tid >> 6, l15 = lane & 15, q4 = lane >> 4, hd = wv < 6 ? wv : 5;
    bf16x8 gf[4][2];
#pragma unroll
    for (int dt = 0; dt < 4; ++dt)
#pragma unroll
      for (int s2 = 0; s2 < 2; ++s2) {
        const float* gp = g_up + (size_t)(32 * s2 + 8 * q4) * AW + hd * 64 + dt * 16 + l15;
        u32x4 w; w.x = pkbf(gp[0], gp[AW]); w.y = pkbf(gp[2 * AW], gp[3 * AW]); w.z = pkbf(gp[4 * AW], gp[5 * AW]); w.w = pkbf(gp[6 * AW], gp[7 * AW]);
        gf[dt][s2] = __builtin_bit_cast(bf16x8, w);
      }
    float gng[4], gnb[4];
#pragma unroll
    for (int dt = 0; dt < 4; ++dt) { gng[dt] = gn_g[hd * 64 + dt * 16 + l15]; gnb[dt] = gn_b[hd * 64 + dt * 16 + l15]; }
    bf16_t gcur[2], gprv[2]; _Float16 yv[16], bv[16], yn[16], bn[16];
    const float mul0 = mu[1216 + (tid & 63)];
    auto fin_fetch = [&](int tile, bf16_t (&gc)[2], bf16_t (&gp)[2], _Float16 (&y)[16], _Float16 (&bb)[16]) {
      const int tok0 = tile * 16;
#pragma unroll
      for (int q = 0; q < 2; ++q) { const int e = tid + 512 * q, i = e >> 6, j = e & 63, tok = tok0 + i, t = tok & (TSEQ - 1);
        gc[q] = P[(size_t)tok * PW + 1216 + j]; gp[q] = t > 0 ? P[(size_t)(tok - 1) * PW + 1216 + j] : (bf16_t)0; }
#pragma unroll
      for (int i = 0; i < 4; ++i)
#pragma unroll
        for (int dt = 0; dt < 4; ++dt) { const size_t o = (size_t)(tok0 + 4 * q4 + i) * AW + hd * 64 + dt * 16 + l15; y[i * 4 + dt] = YH[o]; bb[i * 4 + dt] = BON[o]; }
    };
    fin_fetch(bid, gcur, gprv, yv, bv);
    for (int r3 = 0; r3 < (REPK == 63 ? 2 : 1); ++r3)
    for (int tile = bid; tile < 1024; tile += G) {
      const int tok0 = tile * 16;
#pragma unroll
      for (int q = 0; q < 2; ++q) { const int e = tid + 512 * q; const float gc = bf2f(gcur[q]), gp = bf2f(gprv[q]); sgb[(e >> 6) * 72 + (e & 63)] = (unsigned short)(pkbf(sigmoidf_(gc + mul0 * (gp - gc)), 0.f) & 0xffffu); }
      __syncthreads();
      { const int nt = (tile + G < 1024) ? tile + G : tile; fin_fetch(nt, gcur, gprv, yn, bn); }
      __builtin_amdgcn_sched_barrier(0);
      if (wv < 6) {
        const bf16x8 a0 = *(const LAS bf16x8*)(sgb + l15 * 72 + 8 * q4), a1 = *(const LAS bf16x8*)(sgb + l15 * 72 + 32 + 8 * q4);
        f32x4 gacc[4];
#pragma unroll
        for (int dt = 0; dt < 4; ++dt) {
          gacc[dt] = (f32x4){0.f, 0.f, 0.f, 0.f};
          gacc[dt] = __builtin_amdgcn_mfma_f32_16x16x32_bf16(a0, gf[dt][0], gacc[dt], 0, 0, 0);
          gacc[dt] = __builtin_amdgcn_mfma_f32_16x16x32_bf16(a1, gf[dt][1], gacc[dt], 0, 0, 0);
        }
#pragma unroll
        for (int i = 0; i < 4; ++i) {
          const size_t tok = tok0 + 4 * q4 + i;
          float y[4], sum = 0.f;
#pragma unroll
          for (int dt = 0; dt < 4; ++dt) { y[dt] = (float)yv[i * 4 + dt]; sum += y[dt]; }
          const float mean = allreduce16(sum) * (1.0f / 64.0f);
          float var = 0.f;
#pragma unroll
          for (int dt = 0; dt < 4; ++dt) { y[dt] -= mean; var += y[dt] * y[dt]; }
          const float rs = __builtin_amdgcn_rsqf(allreduce16(var) * (1.0f / 64.0f) + 64e-5f);
#pragma unroll
          for (int dt = 0; dt < 4; ++dt) {
            const float o = (y[dt] * rs * gng[dt] + gnb[dt] + (float)bv[i * 4 + dt]) * gacc[dt][i];
            Y[tok * DM + hd * 64 + dt * 16 + l15] = (bf16_t)(pkbf(o, 0.f) & 0xffffu);
          }
        }
      }
#pragma unroll
      for (int i = 0; i < 16; ++i) { yv[i] = yn[i]; bv[i] = bn[i]; }
      __syncthreads();
    }
  }
}

constexpr int XK_PITCH = 528, XV_PITCH = 80, XK_BYTES = 32 * XK_PITCH, XV_BYTES = 256 * XV_PITCH, XBUF = XK_BYTES + XV_BYTES;
DI void phase_xattn(KP p, LAS unsigned char* lds, int tid, int bid, int G) {
  const bf16_t* QC = (const bf16_t*)(p->ws + WS_U); bf16_t* OC = (bf16_t*)(p->ws + WS_U + (size_t)MTOK * DM * 2);
  const bf16_t* KNC = (const bf16_t*)(p->ws + WS_KNC); const bf16_t* VTC = (const bf16_t*)(p->ws + WS_VTC);
  const int lane = tid & 63, wave = tid >> 6, c = lane & 31, hh = lane >> 5, qb = wave >> 1, dh = wave & 1;
  const int lk = tid >> 4, lp = tid & 15, ld = tid >> 1, lh = tid & 1;
  for (int u = bid; u < 512; u += G) {
    const int b = u >> 6, h = (u >> 4) & 3, qg = u & 15;
    const size_t qrow = (size_t)(b * TSEQ + qg * 128 + qb * 32 + c);
    const bf16_t* qp = QC + qrow * DM + h * 256 + 8 * hh;
    bf16x8 qreg[16]; float sq = 0.f;
#pragma unroll
    for (int s = 0; s < 16; ++s) { qreg[s] = *(const bf16x8*)(qp + 16 * s); sq += sumsq8(qreg[s]); }
    sq += __shfl_xor(sq, 32);
    const float sc = __builtin_amdgcn_rsqf(sq * (1.0f / 256.0f) + RMS_EPS) * 0.0625f * LOG2E;
    const bf16_t* ksrc = KNC + (size_t)(b * 256 + lk) * 1024 + h * 256 + lp * 16;
    const bf16_t* vsrc = VTC + ((size_t)(b * 4 + h) * 256 + ld) * 256 + lh * 16;
    u32x4 kr0 = *(const u32x4*)ksrc, kr1 = *(const u32x4*)(ksrc + 8), vr0 = *(const u32x4*)vsrc, vr1 = *(const u32x4*)(vsrc + 8);
    __syncthreads();
    { LAS unsigned char* kb = lds + lk * XK_PITCH + lp * 32; *(LAS u32x4*)kb = kr0; *(LAS u32x4*)(kb + 16) = kr1;
      LAS unsigned char* vb = lds + XK_BYTES + ld * XV_PITCH + lh * 32; *(LAS u32x4*)vb = vr0; *(LAS u32x4*)(vb + 16) = vr1; }
    __syncthreads();
    f32x16 o[4];
#pragma unroll
    for (int dt = 0; dt < 4; ++dt)
#pragma unroll
      for (int i = 0; i < 16; ++i) o[dt][i] = 0.f;
    float m = -1e30f, lsum = 0.f;
#pragma unroll 1
    for (int kt = 0; kt < 8; ++kt) {
      if (kt + 1 < 8) { const bf16_t* ks = ksrc + (size_t)(kt + 1) * 32 * 1024; const bf16_t* vs = vsrc + (kt + 1) * 32;
        kr0 = *(const u32x4*)ks; kr1 = *(const u32x4*)(ks + 8); vr0 = *(const u32x4*)vs; vr1 = *(const u32x4*)(vs + 8); }
      const LAS unsigned char* kbase = lds + (kt & 1) * XBUF + c * XK_PITCH + hh * 16;
      const LAS unsigned char* vbase = lds + (kt & 1) * XBUF + XK_BYTES + (dh * 128 + c) * XV_PITCH + hh * 8;
      f32x16 st;
#pragma unroll
      for (int i = 0; i < 16; ++i) st[i] = 0.f;
#pragma unroll
      for (int s = 0; s < 16; ++s) st = MFMA32(*(const LAS bf16x8*)(kbase + s * 32), qreg[s], st);
      float tmax = -1e30f;
#pragma unroll
      for (int i = 0; i < 16; ++i) { st[i] *= sc; tmax = fmaxf(tmax, st[i]); }
      tmax = fmaxf(tmax, __shfl_xor(tmax, 32));
      const float mn = fmaxf(m, tmax), alpha = __builtin_amdgcn_exp2f(m - mn); m = mn;
      float psum = 0.f;
#pragma unroll
      for (int i = 0; i < 16; ++i) { st[i] = __builtin_amdgcn_exp2f(st[i] - mn); psum += st[i]; }
      lsum = lsum * alpha + psum;
      const bf16x8 p0 = pack8(st, 0), p1 = pack8(st, 1);
      const bool resc = __builtin_amdgcn_ballot_w64(alpha != 1.0f) != 0ull;
#pragma unroll
      for (int dt = 0; dt < 4; ++dt) {
        if (resc) {
#pragma unroll
          for (int i = 0; i < 16; ++i) o[dt][i] *= alpha; }
        const LAS unsigned char* vp = vbase + dt * 32 * XV_PITCH;
        const u32x2 a0 = *(const LAS u32x2*)vp, a1 = *(const LAS u32x2*)(vp + 16), a2 = *(const LAS u32x2*)(vp + 32), a3 = *(const LAS u32x2*)(vp + 48);
        u32x4 w0; w0.x = a0.x; w0.y = a0.y; w0.z = a1.x; w0.w = a1.y;
        u32x4 w1; w1.x = a2.x; w1.y = a2.y; w1.z = a3.x; w1.w = a3.y;
        o[dt] = MFMA32(__builtin_bit_cast(bf16x8, w0), p0, o[dt]);
        o[dt] = MFMA32(__builtin_bit_cast(bf16x8, w1), p1, o[dt]);
      }
      if (kt + 1 < 8) {
        LAS unsigned char* nb = lds + ((kt + 1) & 1) * XBUF;
        LAS unsigned char* kb = nb + lk * XK_PITCH + lp * 32; *(LAS u32x4*)kb = kr0; *(LAS u32x4*)(kb + 16) = kr1;
        LAS unsigned char* vb = nb + XK_BYTES + ld * XV_PITCH + lh * 32; *(LAS u32x4*)vb = vr0; *(LAS u32x4*)(vb + 16) = vr1;
      }
      __syncthreads();
    }
    lsum += __shfl_xor(lsum, 32);
    const float linv = __builtin_amdgcn_rcpf(lsum);
    bf16_t* op = OC + qrow * DM + h * 256 + dh * 128 + 4 * hh;
#pragma unroll
    for (int dt = 0; dt < 4; ++dt)
#pragma unroll
      for (int g = 0; g < 4; ++g) {
        u32x2 w; w.x = pkbf(o[dt][4 * g] * linv, o[dt][4 * g + 1] * linv); w.y = pkbf(o[dt][4 * g + 2] * linv, o[dt][4 * g + 3] * linv);
        *(u32x2*)(op + dt * 32 + 8 * g) = w;
      }
  }
}

#define XB_TMO      128
#define XB_XCNT(j)  (256  + 64 * (j))
#define XB_XSUB(j)  (1280 + 64 * (j))
#define XB_XGEN(j)  (2304 + 64 * (j))
#define XB_TOP      3328
#define XB_TOPGEN   3392
#define XB_XSUB(j)  (1280 + 64 * (j))
#define XB_XGEN(j)  (2304 + 64 * (j))
#define XB_TOP      3328
#define XB_TOPGEN   3392
#define XCD_BAR_WORDS 3456
#define XB_SPIN_CAP (1u << 18)

DI unsigned xb_ld(unsigned* p)              { return __hip_atomic_load(p, __ATOMIC_RELAXED, __HIP_MEMORY_SCOPE_AGENT); }
DI unsigned xb_add(unsigned* p, unsigned v) { return __hip_atomic_fetch_add(p, v, __ATOMIC_RELAXED, __HIP_MEMORY_SCOPE_AGENT); }
DI unsigned xb_xcc_id() { return (unsigned)__builtin_amdgcn_s_getreg((3 << 11) | 20) & 0xFu; }
#define XB_SPIN(cond, bar) do { unsigned _sp = 0; while (cond) { __builtin_amdgcn_s_sleep(1); \
    if ((++_sp & 255u) == 0u) { if (xb_ld(&(bar)[XB_TMO])) break; if (_sp > XB_SPIN_CAP) { atomicAdd(&(bar)[XB_TMO], 1u); break; } } } } while (0)

struct XcdBarrier {
    unsigned* bar; unsigned x;
    volatile LAS unsigned* st;
};

DI XcdBarrier xcd_barrier_post(unsigned* bar, volatile LAS unsigned* st) {
    XcdBarrier b; b.bar = bar; b.x = xb_xcc_id(); b.st = st;
    if (threadIdx.x == 0) (void)xb_add(&bar[XB_XCNT(b.x)], 1u);
    return b;
}
DI void xcd_barrier_complete(unsigned* bar, unsigned x, unsigned& nloc, unsigned& nx) {
    const unsigned G = gridDim.x * gridDim.y * gridDim.z;
    unsigned sum, cnt, mine, sp = 0u;
    for (;;) {
        sum = 0u; cnt = 0u; mine = 0u;
#pragma unroll
        for (unsigned j = 0; j < 16; ++j) { const unsigned c = xb_ld(&bar[XB_XCNT(j)]); sum += c; cnt += (c > 0u) ? 1u : 0u; mine = (j == x) ? c : mine; }
        if (sum == G) break;
        __builtin_amdgcn_s_sleep(1);
        if ((++sp & 255u) == 0u) { if (xb_ld(&bar[XB_TMO])) break; if (sp > XB_SPIN_CAP) { atomicAdd(&bar[XB_TMO], 1u); break; } }
    }
    nloc = mine > 0u ? mine : 1u; nx = cnt > 0u ? cnt : 1u;
}

DI void xcd_barrier(const XcdBarrier& b) {
    asm volatile("s_waitcnt vmcnt(0)" ::: "memory");
    __syncthreads();
    if (threadIdx.x == 0) {
        unsigned* bar = b.bar;
        __builtin_amdgcn_s_waitcnt(0);
        unsigned nloc = b.st[0], nx = b.st[1];
        if (nloc == 0u) { xcd_barrier_complete(bar, b.x, nloc, nx); b.st[0] = nloc; b.st[1] = nx; }
        const unsigned old = xb_add(&bar[XB_XSUB(b.x)], 1u);
        const unsigned gen = old / nloc;
        if (old + 1u == (gen + 1u) * nloc) {
            __builtin_amdgcn_fence(__ATOMIC_RELEASE, "agent");
            asm volatile("s_waitcnt vmcnt(0)" ::: "memory");
            const unsigned og = xb_add(&bar[XB_TOP], 1u);
            const unsigned tg = og / nx;
            if (og + 1u == (tg + 1u) * nx) xb_add(&bar[XB_TOPGEN], 1u);
            else XB_SPIN(xb_ld(&bar[XB_TOPGEN]) == tg, bar);
            __builtin_amdgcn_fence(__ATOMIC_ACQUIRE, "agent");
            xb_add(&bar[XB_XGEN(b.x)], 1u);
            asm volatile("s_waitcnt vmcnt(0)" ::: "memory");
        } else {
            XB_SPIN(xb_ld(&bar[XB_XGEN(b.x)]) == gen, bar);
            __builtin_amdgcn_fence(__ATOMIC_ACQUIRE, "agent");
            asm volatile("s_waitcnt vmcnt(0)" ::: "memory");
        }
    }
    __syncthreads();
}

constexpr int LDS_BYTES = 131072 + 64;
constexpr int N_PHASES = 30;
constexpr int SCAN_BLOCKS = 192;
#ifndef HIDE_CONV
#define HIDE_CONV 1
#endif
constexpr int CONV_A = 16 * 176 + 44 * 32 + 16 * 88 + 16 * 64, CONV_ALL = 2 * 16 * 176 + 2 * 44 * 32 + 16 * 88 + 16 * 64 + 3 * 16 * 32;
#ifndef PH_MASK
#define PH_MASK 0xff
#endif
#define EN(k) (((PH_MASK) >> (k)) & 1)
#ifndef REPK
#define REPK -1
#endif
__global__ void __launch_bounds__(512, 2) mk_fwd(Params p) {
  extern __shared__ __attribute__((aligned(16))) unsigned char lds_raw[];
  LAS unsigned char* lds = (LAS unsigned char*)lds_raw;
  cg::grid_group grid = cg::this_grid();
  const int ph_lo = p.ph_lo, ph_hi = p.ph_hi;
  volatile LAS unsigned* bst = (volatile LAS unsigned*)(lds + 131072);
  if (threadIdx.x < 2) bst[threadIdx.x] = 0u;
  __syncthreads();
  XcdBarrier xbar = xcd_barrier_post((unsigned*)(p.ws + WS_BAR), bst);
  int rep = 0; unsigned nbar = 0;
#pragma unroll 1
  for (int ph = ph_lo; ph < ph_hi;) {
    KP kp = (KP)__builtin_amdgcn_kernarg_segment_ptr();
    asm volatile("" : "+s"(kp));
    int tid = threadIdx.x; asm volatile("" : "+v"(tid));
    int bid = blockIdx.x; asm volatile("" : "+s"(bid));
    int G = gridDim.x; asm volatile("" : "+s"(G));
    const int lane = tid & 63, wave = __builtin_amdgcn_readfirstlane(tid >> 6);
    const int gw = bid * 8 + wave, NGW = G * 8;
    unsigned char* ws = kp->ws; unsigned char* W = ws + WS_W;
    bf16_t* XB = (bf16_t*)(ws + WS_XB); float* SS = (float*)(ws + WS_SS); bf16_t* U = (bf16_t*)(ws + WS_U);
    const int l = ph >= 15 ? 1 : 0, s = ph - 15 * l;
    if (s == 6 || s == 7) { ++ph; continue; }
    if (EN(0) && s == 0) {
      phase_conv(kp, l, lds, gw, NGW, wave, lane, 0, CONV_ALL);
      if (l == 0) phase_init(kp, gw, NGW, lane, 0);
    } else if (EN(1) && (s == 1 || s == 13)) {
      pg8::Gemm g{XB, (const bf16_t*)(W + (s == 1 ? W_WI1 : W_WI2)), MTOK, 5632, 1024};
      pg8::StaticOrder S; S.init(MTOK, 5632, G, bid);
      EpiSwiGLU E{U, SS};
      pg8::gemm_phase<EpiSwiGLU, pg8::StaticOrder, true, true>(lds, g, S, E, tid);
    } else if (EN(2) && (s == 2 || s == 14 || s == 9 || s == 12)) {
      const bf16_t* A = (s == 9) ? (const bf16_t*)(ws + WS_Y) : (s == 12) ? (const bf16_t*)(ws + WS_U + (size_t)MTOK * DM * 2) : (const bf16_t*)U;
      const size_t wo = (s == 2) ? W_WO1 : (s == 14) ? W_WO2 : (s == 9) ? W_WOUT : W_WOX;
      pg8::Gemm g{A, (const bf16_t*)(W + wo), MTOK, 1024, (s == 2 || s == 14) ? 2816 : 1024};
      pg8::StaticOrder S; S.init(MTOK, 1024, G, bid);
      EpiResid E{kp->in[0], kp->out, XB, SS, (s == 2 || s == 14) ? 0.5f : 1.0f, ph == 2, ph == N_PHASES - 1};
      pg8::gemm_phase<EpiResid, pg8::StaticOrder, true, true>(lds, g, S, E, tid);
    } else if (EN(3) && (s == 3 || s == 10)) {
      pg8::Gemm g{XB, (const bf16_t*)(W + (s == 3 ? W_WIN : W_WQ)), MTOK, 1024, 1024};
      WinOrder S; S.init(s == 3 ? 2816 : 1024, G, bid, s == 3);
      EpiScaleBf16 E{U, s == 3 ? PW : DM, SS, (bf16_t*)(ws + WS_KVC), 2048, (const float*)(ws + WS_RSM)};
      pg8::gemm_phase<EpiScaleBf16, WinOrder, true, true>(lds, g, S, E, tid);
    } else if (EN(4) && (s == 4 || s == 6)) {
      phase_prep_rwkv(kp, l, 0, lds, tid, bid, G);
      if (s == 4 && rep == 0) { phase_attn_prep<0>(kp, l, lds, gw, NGW, wave, lane); if (G <= SCAN_BLOCKS) phase_attn_prep<1>(kp, l, lds, gw, NGW, wave, lane); }
    } else if (EN(5) && (s == 5 || s == 7)) {
      if (G > SCAN_BLOCKS && bid >= SCAN_BLOCKS) {
        phase_chunk(kp, l, lds, tid, (bid - SCAN_BLOCKS) * 8 + wave, (G - SCAN_BLOCKS) * 8, 0, 1536);
        __syncthreads();
        phase_attn_prep<1>(kp, l, lds, (bid - SCAN_BLOCKS) * 8 + wave, (G - SCAN_BLOCKS) * 8, wave, lane);
      }
      phase_scan(kp, 0, lds, tid, bid);
    } else if (EN(6) && s == 8) {
      if (G <= SCAN_BLOCKS) { phase_chunk(kp, l, lds, tid, gw, NGW, 0, 1536); __syncthreads(); }
      phase_attn(kp, l, lds, tid, gw, NGW, bid, G);
    } else if (EN(7) && s == 11) {
      phase_xattn(kp, lds, tid, bid, G);
    }
    if (REPK >= 0 && REPK < 9) {
      const int kind = (s == 0) ? 0 : (s == 1 || s == 13) ? 1 : (s == 3 || s == 10) ? 3 : (s == 4 || s == 6) ? 4 : (s == 5 || s == 7) ? 5 : (s == 8) ? 6 : (s == 11) ? 7 : 2;
      if (kind == REPK && rep == 0) { rep = 1; if (REPK == 2) xcd_barrier(xbar); __syncthreads(); continue; }
      rep = 0;
    }
    if (ph + 1 < ph_hi) {
      if (ph_hi > 1000) grid.sync();
      xcd_barrier(xbar); if (REPK == 9) xcd_barrier(xbar);
    }
    ++ph;
  }
}

extern "C" void kernel_launch(void* const* d_in, const int* in_sizes, int n_in, void* d_out, int out_size, void* d_ws, size_t ws_size, hipStream_t stream) {
  static int grid = 0;
  if (grid == 0) {
    if (n_in != 37 || out_size != MTOK * DM || ws_size < WS_END) { fprintf(stderr, "kernel_launch: unexpected shapes / workspace (n_in %d out %d ws %zu need %zu)\n", n_in, out_size, ws_size, (size_t)WS_END); grid = -1; return; }
    int dev = 0, cus = 0, per_cu = 0;
    (void)hipGetDevice(&dev);
    (void)hipDeviceGetAttribute(&cus, hipDeviceAttributeMultiprocessorCount, dev);
    (void)hipFuncSetAttribute((const void*)mk_fwd, hipFuncAttributeMaxDynamicSharedMemorySize, LDS_BYTES);
    (void)hipOccupancyMaxActiveBlocksPerMultiprocessor(&per_cu, (const void*)mk_fwd, 512, LDS_BYTES);
    if (per_cu < 1) { fprintf(stderr, "kernel_launch: occupancy query says %d blocks/CU\n", per_cu); per_cu = 1; }
    if (cus < SCAN_BLOCKS) { fprintf(stderr, "kernel_launch: this kernel needs >= %d CUs (found %d)\n", SCAN_BLOCKS, cus); grid = -1; return; }
    grid = cus;
    (void)hipGetLastError();
  }
  if (grid < 0) return;
  Params p{};
  for (int i = 0; i < 37; ++i) p.in[i] = (const float*)d_in[i];
  p.out = (float*)d_out; p.ws = (unsigned char*)d_ws;
  (void)hipMemsetAsync((unsigned char*)d_ws + WS_BAR, 0, 16384, stream);
#if MK_LAUNCHES == 1
  p.ph_lo = 0; p.ph_hi = N_PHASES;
  void* args[] = {&p};
  hipError_t e = hipLaunchCooperativeKernel((const void*)mk_fwd, dim3(grid), dim3(512), args, LDS_BYTES, stream);
  if (e != hipSuccess) fprintf(stderr, "cooperative launch failed: %s (grid %d)\n", hipGetErrorString(e), grid);
#else
  for (int ph = 0; ph < N_PHASES; ++ph) { p.ph_lo = ph; p.ph_hi = ph + 1; hipLaunchKernelGGL(mk_fwd, dim3(grid), dim3(512), LDS_BYTES, stream, p); }
#endif
}
```

```cpp
#include <hip/hip_runtime.h>
#include <hip/hip_cooperative_groups.h>
#include <cstdio>
#include <cstdint>
namespace cg = cooperative_groups;

#ifndef REPK
#define REPK -1
#endif
#ifndef MK_LAUNCHES
#define MK_LAUNCHES 1
#endif

namespace pg8 {
#define PG8_LAS __attribute__((address_space(3)))
typedef unsigned short bf16_t;
typedef short bf16x8 __attribute__((ext_vector_type(8)));
typedef float f32x4 __attribute__((ext_vector_type(4)));
typedef unsigned u32x4 __attribute__((ext_vector_type(4)));
constexpr int BM = 256, BK = 64, HALF = 128, HTB = HALF * BK * 2  , STAGE_BYTES = 8 * HTB, NXCD = 8, WGM = 8;

__host__ __device__ __forceinline__ int lds_byte(int r, int c) { const int st = (r >> 4) * 2 + (c >> 5), rr = r & 15, cc = c & 31, ob = rr * 64 + cc * 2; return st * 1024 + (ob ^ (((ob >> 9) & 1) << 5)); }
__host__ __device__ __forceinline__ void stage_rc(int b, int& R, int& C) { const int st = b / 1024, sb = b % 1024, swz = sb ^ (((sb >> 9) & 1) << 5); R = (st >> 1) * 16 + swz / 64; C = (st & 1) * 32 + (swz % 64) / 2; }
__host__ __device__ __forceinline__ int perm32(int rho) { const int n = rho >> 4, i = rho & 15; return 8 * (i >> 2) + 4 * n + (i & 3); }

struct Unit { int pm, pn; };
struct Gemm { const bf16_t* A; const bf16_t* Bt; int M, N, K; };

struct StaticOrder {
    int nM, nN, nwg, G, c;
    __host__ __device__ void init(int M, int N, int G_, int c_) { nM = M / BM; nN = N / BM; nwg = nM * nN; G = G_; c = c_; }
    __host__ __device__ bool next(int i, Unit& u) const {
        const long L = (long)i * G + c; if (L >= nwg) return false;
        int wgid = (int)L; { const int q = nwg / NXCD, r = nwg % NXCD, xcd = wgid % NXCD, off = wgid / NXCD; wgid = (xcd < r ? xcd * (q + 1) : r * (q + 1) + (xcd - r) * q) + off; }
        const int nig = WGM * nN, gid = wgid / nig, fm = gid * WGM, gsz = (nM - fm) < WGM ? (nM - fm) : WGM;
        u.pm = fm + ((wgid % nig) % gsz); u.pn = (wgid % nig) / gsz; return true;
    }
    __device__ __forceinline__ void a_ready(const Unit&) const {}
    __device__ __forceinline__ void done(const Unit&) const {}
};

template <class Epi, class Sched, bool ALIGN_EPI = false, bool SP2 = false>
__device__ __forceinline__ void gemm_phase(PG8_LAS unsigned char* lds, const Gemm g, const Sched& S, const Epi& E, const int tid) {
    const int wid = __builtin_amdgcn_readfirstlane(tid >> 6), lane = tid & 63, wr = wid >> 2, wc = wid & 3, fr = lane & 15, fq = lane >> 4;
    const int K = g.K, nt = K / BK;
    unsigned voffA[2], voffB[2];
#pragma unroll
    for (int i = 0; i < 2; ++i) { int R, C; stage_rc(tid * 16 + i * 8192, R, C); const int Rb = Epi::PERM ? ((R & ~31) + perm32(R & 31)) : R;
        voffA[i] = (unsigned)(R * K + C) * 2u; voffB[i] = (unsigned)(Rb * K + C) * 2u; }
    const size_t kstep = (size_t)(BK * 2);
    const size_t hstep = (size_t)HALF * K * 2;
    const size_t tstep = 2 * hstep;
    const unsigned ldsw = (unsigned)wid * 1024u;
    const int aoff = lds_byte(wr * 64 + fr, fq * 8), boff = lds_byte(wc * 32 + fr, fq * 8);
#define PG8_SA(b, h) (((b) * 2 + (h)) * HTB)
#define PG8_SB(b, h) ((4 + (b) * 2 + (h)) * HTB)
#define PG8_STAGE(bufoff, gbase, voff) do { _Pragma("unroll") for (int _i = 0; _i < 2; ++_i) \
        __builtin_amdgcn_global_load_lds((const unsigned*)((const char*)(gbase) + (voff)[_i]), (PG8_LAS unsigned*)(lds + (bufoff) + ldsw + _i * 8192), 16, 0, 0); } while (0)
#define PG8_LDA(dst, b, h) do { _Pragma("unroll") for (int m = 0; m < 4; ++m) _Pragma("unroll") for (int k = 0; k < 2; ++k) dst[m][k] = *(const PG8_LAS bf16x8*)(lds + PG8_SA(b, h) + aoff + m * 2048 + k * 1024); } while (0)
#define PG8_LDB(dst, b, h) do { _Pragma("unroll") for (int n = 0; n < 2; ++n) _Pragma("unroll") for (int k = 0; k < 2; ++k) dst[n][k] = *(const PG8_LAS bf16x8*)(lds + PG8_SB(b, h) + boff + n * 2048 + k * 1024); } while (0)
#define PG8_MMA(ai, bj, At, Bt) do { __builtin_amdgcn_s_setprio(1); _Pragma("unroll") for (int m = 0; m < 4; ++m) _Pragma("unroll") for (int n = 0; n < 2; ++n) _Pragma("unroll") for (int k = 0; k < 2; ++k) \
        acc[ai][bj][m][n] = __builtin_amdgcn_mfma_f32_16x16x32_bf16(Bt[n][k], At[m][k], acc[ai][bj][m][n], 0, 0, 0); __builtin_amdgcn_s_setprio(0); } while (0)
#define PG8_WAIT_V(n) asm volatile("s_waitcnt vmcnt(" #n ")" ::: "memory")
#define PG8_WAIT_L(n) asm volatile("s_waitcnt lgkmcnt(" #n ")" ::: "memory")
#define PG8_BAR __builtin_amdgcn_s_barrier()
#define PG8_SCHED __builtin_amdgcn_sched_barrier(0)
    Unit cur, nxt; int ui = 0;
    if (!S.next(0, cur)) return;
    f32x4 acc[2][2][4][2];
#pragma unroll
    for (int a = 0; a < 2; ++a)
#pragma unroll
        for (int b = 0; b < 2; ++b)
#pragma unroll
            for (int m = 0; m < 4; ++m)
#pragma unroll
                for (int n = 0; n < 2; ++n) acc[a][b][m][n] = (f32x4){0.f, 0.f, 0.f, 0.f};
    bf16x8 At[4][2], B0[2][2], B1[2][2];
    const char* cA = (const char*)g.A + (size_t)cur.pm * tstep; const char* cB = (const char*)g.Bt + (size_t)cur.pn * tstep;
    S.a_ready(cur);
    if constexpr (SP2) {
        PG8_STAGE(PG8_SB(0, 0), cB, voffB); PG8_STAGE(PG8_SB(0, 1), cB + hstep, voffB); PG8_STAGE(PG8_SA(0, 0), cA, voffA); PG8_STAGE(PG8_SA(0, 1), cA + hstep, voffA);
        if (wr == 1) PG8_BAR;
        PG8_WAIT_V(2); PG8_BAR;
        PG8_STAGE(PG8_SB(1, 0), cB + kstep, voffB); PG8_STAGE(PG8_SA(1, 0), cA + kstep, voffA); PG8_STAGE(PG8_SB(1, 1), cB + hstep + kstep, voffB);
        PG8_WAIT_V(6); PG8_BAR;
    } else {
        PG8_STAGE(PG8_SB(0, 0), cB, voffB); PG8_STAGE(PG8_SA(0, 0), cA, voffA); PG8_STAGE(PG8_SB(0, 1), cB + hstep, voffB); PG8_STAGE(PG8_SA(0, 1), cA + hstep, voffA);
        if (wr == 1) PG8_BAR;
        PG8_WAIT_V(4); PG8_BAR;
        PG8_STAGE(PG8_SB(1, 0), cB + kstep, voffB); PG8_STAGE(PG8_SA(1, 0), cA + kstep, voffA); PG8_STAGE(PG8_SB(1, 1), cB + hstep + kstep, voffB);
        PG8_WAIT_V(6); PG8_BAR;
    }
    for (;;) {
        const bool has_next = S.next(ui + 1, nxt);
        const char* nA = has_next ? (const char*)g.A + (size_t)nxt.pm * tstep : cA; const char* nB = has_next ? (const char*)g.Bt + (size_t)nxt.pn * tstep : cB;
        for (int t = 0; t < nt; t += 2) {
            const bool last = (t == nt - 2);
            const char* a1 = cA + (size_t)(t + 1) * kstep;
            const char* a2 = last ? nA : cA + (size_t)(t + 2) * kstep; const char* b2 = last ? nB : cB + (size_t)(t + 2) * kstep;
            const char* a3 = a2 + kstep; const char* b3 = b2 + kstep;
            if (last && has_next) S.a_ready(nxt);
            if constexpr (SP2) {
            PG8_LDB(B0, 0, 0); PG8_LDB(B1, 0, 1); PG8_SCHED; PG8_LDA(At, 0, 0); PG8_STAGE(PG8_SA(1, 1), a1 + hstep, voffA);
            PG8_WAIT_V(8); PG8_WAIT_L(0); PG8_BAR; PG8_MMA(0, 0, At, B0); PG8_MMA(0, 1, At, B1); PG8_BAR; PG8_SCHED;
            PG8_LDA(At, 0, 1); PG8_STAGE(PG8_SB(0, 0), b2, voffB); PG8_STAGE(PG8_SB(0, 1), b2 + hstep, voffB); PG8_STAGE(PG8_SA(0, 0), a2, voffA);
            PG8_WAIT_V(8); PG8_WAIT_L(0); PG8_BAR; PG8_MMA(1, 0, At, B0); PG8_MMA(1, 1, At, B1); PG8_BAR; PG8_SCHED;
            PG8_LDB(B0, 1, 0); PG8_LDB(B1, 1, 1); PG8_SCHED; PG8_LDA(At, 1, 0); PG8_STAGE(PG8_SA(0, 1), a2 + hstep, voffA);
            PG8_WAIT_V(8); PG8_WAIT_L(0); PG8_BAR; PG8_MMA(0, 0, At, B0); PG8_MMA(0, 1, At, B1); PG8_BAR; PG8_SCHED;
            PG8_LDA(At, 1, 1); PG8_STAGE(PG8_SB(1, 0), b3, voffB); PG8_STAGE(PG8_SB(1, 1), b3 + hstep, voffB); PG8_STAGE(PG8_SA(1, 0), a3, voffA);
            PG8_WAIT_V(8); PG8_WAIT_L(0); PG8_BAR; PG8_MMA(1, 0, At, B0); PG8_MMA(1, 1, At, B1); PG8_BAR; PG8_SCHED;
            } else {
            PG8_LDB(B0, 0, 0); PG8_SCHED; PG8_LDA(At, 0, 0); PG8_STAGE(PG8_SA(1, 1), a1 + hstep, voffA);
            PG8_WAIT_L(8); PG8_BAR; PG8_WAIT_L(0); PG8_MMA(0, 0, At, B0); PG8_BAR; PG8_SCHED;
            PG8_LDB(B1, 0, 1); PG8_STAGE(PG8_SB(0, 0), b2, voffB);
            PG8_BAR; PG8_WAIT_L(0); PG8_MMA(0, 1, At, B1); PG8_BAR;
            PG8_LDA(At, 0, 1); PG8_STAGE(PG8_SA(0, 0), a2, voffA);
            PG8_BAR; PG8_WAIT_L(0); PG8_MMA(1, 0, At, B0); PG8_BAR; PG8_SCHED;
            PG8_STAGE(PG8_SB(0, 1), b2 + hstep, voffB);
            PG8_WAIT_V(6); PG8_BAR; PG8_MMA(1, 1, At, B1); PG8_BAR;
            PG8_LDB(B0, 1, 0); PG8_SCHED; PG8_LDA(At, 1, 0); PG8_STAGE(PG8_SA(0, 1), a2 + hstep, voffA);
            PG8_WAIT_L(8); PG8_BAR; PG8_WAIT_L(0); PG8_MMA(0, 0, At, B0); PG8_BAR; PG8_SCHED;
            PG8_LDB(B1, 1, 1); PG8_STAGE(PG8_SB(1, 0), b3, voffB);
            PG8_BAR; PG8_WAIT_L(0); PG8_MMA(0, 1, At, B1); PG8_BAR;
            PG8_LDA(At, 1, 1); PG8_STAGE(PG8_SA(1, 0), a3, voffA);
            PG8_BAR; PG8_WAIT_L(0); PG8_MMA(1, 0, At, B0); PG8_BAR; PG8_SCHED;
            PG8_STAGE(PG8_SB(1, 1), b3 + hstep, voffB);
            PG8_WAIT_V(6); PG8_BAR; PG8_MMA(1, 1, At, B1); PG8_BAR;
            }
        }
        if constexpr (ALIGN_EPI) { if (wr == 0) PG8_BAR; }
        if constexpr (!Epi::AFTER_DRAIN) { E(acc, cur, wr, wc, fr, fq); S.done(cur); }
        if (!has_next) break;
#pragma unroll
        for (int a = 0; a < 2; ++a)
#pragma unroll
            for (int b = 0; b < 2; ++b)
#pragma unroll
                for (int m = 0; m < 4; ++m)
#pragma unroll
                    for (int n = 0; n < 2; ++n) acc[a][b][m][n] = (f32x4){0.f, 0.f, 0.f, 0.f};
        cur = nxt; cA = nA; cB = nB; ++ui;
        if constexpr (ALIGN_EPI) { if (wr == 1) PG8_BAR; }
    }
    PG8_WAIT_V(0);
    if constexpr (!ALIGN_EPI) { if (wr == 0) PG8_BAR; }
    PG8_BAR;
    if constexpr (Epi::AFTER_DRAIN) { E.fused(acc, cur, wr, wc, fr, fq, lds, wid, lane); S.done(cur); }
#undef PG8_SA
#undef PG8_SB
#undef PG8_STAGE
#undef PG8_LDA
#undef PG8_LDB
#undef PG8_MMA
#undef PG8_WAIT_V
#undef PG8_WAIT_L
#undef PG8_BAR
#undef PG8_SCHED
}
}

#define LAS __attribute__((address_space(3)))
typedef unsigned short bf16_t;
typedef short bf16x8 __attribute__((ext_vector_type(8)));
typedef short s16x4 __attribute__((ext_vector_type(4)));
typedef float f32x4 __attribute__((ext_vector_type(4)));
typedef float f32x2 __attribute__((ext_vector_type(2)));
typedef float f32x16 __attribute__((ext_vector_type(16)));
typedef unsigned u32x4 __attribute__((ext_vector_type(4)));
typedef unsigned u32x2 __attribute__((ext_vector_type(2)));
typedef _Float16 h4_t __attribute__((ext_vector_type(4)));
typedef _Float16 h8_t __attribute__((ext_vector_type(8)));
typedef __bf16 bfv2_t __attribute__((ext_vector_type(2)));
#define DI __device__ __forceinline__

DI unsigned pkbf(float a, float b) { bfv2_t v = __builtin_convertvector((f32x2){a, b}, bfv2_t); return __builtin_bit_cast(unsigned, v); }
DI float bf2f(unsigned short u) { return __uint_as_float(((unsigned)u) << 16); }
DI float bflo(unsigned u) { return __uint_as_float(u << 16); }
DI float bfhi(unsigned u) { return __uint_as_float(u & 0xffff0000u); }
DI float wave_sum(float v) {
#pragma unroll
  for (int o = 1; o < 64; o <<= 1) v += __shfl_xor(v, o);
  return v;
}
DI float vfma(float a, float b, float c) { float d; asm("v_fma_f32 %0, %1, %2, %3" : "=v"(d) : "v"(a), "v"(b), "v"(c)); return d; }
DI float sigmoidf_(float x) { return __builtin_amdgcn_rcpf(1.0f + __expf(-x)); }
#define LDS_WAIT() asm volatile("s_waitcnt lgkmcnt(0)" ::: "memory")
template <int CTRL> DI float dpp_addx(float x) { return x + __builtin_bit_cast(float, __builtin_amdgcn_update_dpp(0, __builtin_bit_cast(int, x), CTRL, 0xf, 0xf, true)); }
DI float allreduce16(float x) { x = dpp_addx<0xB1>(x); x = dpp_addx<0x4E>(x); x = dpp_addx<0x141>(x); x = dpp_addx<0x140>(x); return x; }
DI float rdlane(float x, int l) { return __builtin_bit_cast(float, __builtin_amdgcn_readlane(__builtin_bit_cast(int, x), l)); }
DI float wave_sum_dpp(float x) { x = allreduce16(x); return (rdlane(x, 0) + rdlane(x, 16)) + (rdlane(x, 32) + rdlane(x, 48)); }


constexpr int MTOK = 16384, DM = 1024, TSEQ = 2048, NB = 8, DFF = 2816, PW = 2816  , NMEM = 256;
constexpr int AW = 384, APROJ = 1280;
constexpr int PQ = 1280, PK = 1664, PV = 2048, PC = 2432;
constexpr int THALF = 1024;
constexpr float RMS_EPS = 1e-6f;

constexpr size_t SZ_WI = (size_t)5632 * 1024 * 2, SZ_WO = (size_t)1024 * 2816 * 2, SZ_WIN = (size_t)2816 * 1024 * 2, SZ_WKV = (size_t)2048 * 1024 * 2, SZ_SQ = (size_t)1024 * 1024 * 2;
constexpr size_t W_WI1 = 0, W_WO1 = W_WI1 + SZ_WI, W_WIN = W_WO1 + SZ_WO, W_WKV = W_WIN + SZ_WIN, W_WOUT = W_WKV + SZ_WKV, W_WQ = W_WOUT + SZ_SQ, W_WOX = W_WQ + SZ_SQ,
                 W_WI2 = W_WOX + SZ_SQ, W_WO2 = W_WI2 + SZ_WI, W_END = W_WO2 + SZ_WO;
constexpr size_t WS_W = 0;
constexpr size_t WS_XB = WS_W + W_END;
constexpr size_t WS_MEMB = WS_XB + (size_t)MTOK * DM * 2;
constexpr size_t WS_U = WS_MEMB + (size_t)2048 * DM * 2;
constexpr size_t WS_R2 = WS_U + (size_t)MTOK * PW * 2;
constexpr size_t WS_VF = WS_R2 + (size_t)48 * THALF * 384 * 2;
constexpr size_t WS_KNC = WS_VF + (size_t)MTOK * AW * 2;
constexpr size_t WS_VTC = WS_KNC + (size_t)2048 * 1024 * 2;
constexpr size_t WS_KVC = WS_VTC + (size_t)2048 * 1024 * 2;
constexpr size_t WS_VTB = WS_KVC + (size_t)2048 * 2048 * 2;
constexpr size_t WS_SS = WS_VTB + (size_t)MTOK * AW * 2;
constexpr size_t WS_RKB = WS_SS + (size_t)MTOK * 16 * 4;
constexpr size_t WS_RSM = WS_RKB + (size_t)48 * 2048 * 4;
constexpr size_t WS_ST = WS_RSM + 2048 * 4;
constexpr size_t WS_BAR = WS_ST + (size_t)48 * 4096 * 4;
constexpr size_t WS_S6X = WS_BAR + 16384;
constexpr size_t S6_BH_BYTES = (size_t)TSEQ * 768;
constexpr size_t WS_END = WS_S6X + 8 * S6_BH_BYTES;
constexpr size_t WS_S6 = WS_XB;
constexpr size_t WS_Y = WS_R2;
constexpr size_t WS_YH = WS_W + W_WI1;
constexpr size_t WS_BON = WS_YH + (size_t)MTOK * AW * 2;
static_assert((size_t)48 * THALF * 384 * 2 == (size_t)(MTOK + 2048) * DM * 2, "S6 half must fit [xb | memb] exactly");
static_assert(2 * (size_t)MTOK * AW * 2 <= W_WOUT, "y + bonus must fit the dead weight prefix");

struct Params { const float* in[37]; float* out; unsigned char* ws; int ph_lo, ph_hi; };
typedef const Params __attribute__((address_space(4)))* KP;
DI unsigned char* s6_block(KP p, int bh) { return bh < 40 ? (unsigned char*)p->out + (size_t)bh * S6_BH_BYTES : p->ws + WS_S6X + (size_t)(bh - 40) * S6_BH_BYTES; }

DI float row_rstd16(const float* ss, int row) {
  const f32x4* p = (const f32x4*)(ss + (size_t)row * 16);
  f32x4 a = p[0], b = p[1], c = p[2], d = p[3];
  float s = ((a[0] + a[1]) + (a[2] + a[3])) + ((b[0] + b[1]) + (b[2] + b[3])) + ((c[0] + c[1]) + (c[2] + c[3])) + ((d[0] + d[1]) + (d[2] + d[3]));
  return __builtin_amdgcn_rsqf(s * (1.0f / 1024.0f) + RMS_EPS);
}
struct EpiScaleBf16 {
  static constexpr bool PERM = true, AFTER_DRAIN = false;
  bf16_t* O1; int ldc1; const float* ss; bf16_t* O2; int ldc2; const float* rs2;
  DI void operator()(const f32x4 (&acc)[2][2][4][2], const pg8::Unit& u, int wr, int wc, int fr, int fq) const {
    const bool kv = u.pm >= 64;
    bf16_t* base = kv ? O2 : O1; const int ldc = kv ? ldc2 : ldc1;
    const int row0 = (kv ? (u.pm - 64) : u.pm) * 256 + wr * 64 + fr, col0 = (kv ? (u.pn - 11) : u.pn) * 256 + wc * 32 + 8 * fq;
#pragma unroll
    for (int ai = 0; ai < 2; ++ai)
#pragma unroll
      for (int m = 0; m < 4; ++m) {
        const int row = row0 + ai * 128 + m * 16;
        const float rs = kv ? rs2[row] : row_rstd16(ss, row);
        bf16_t* rowp = base + (size_t)row * ldc + col0;
#pragma unroll
        for (int bj = 0; bj < 2; ++bj) {
          const f32x4 v0 = acc[ai][bj][m][0] * rs, v1 = acc[ai][bj][m][1] * rs;
          u32x4 w; w.x = pkbf(v0[0], v0[1]); w.y = pkbf(v0[2], v0[3]); w.z = pkbf(v1[0], v1[1]); w.w = pkbf(v1[2], v1[3]);
          *(u32x4*)(rowp + bj * 128) = w;
        }
      }
  }
};
struct EpiSwiGLU {
  static constexpr bool PERM = true, AFTER_DRAIN = false;
  bf16_t* O; const float* ss;
  DI void operator()(const f32x4 (&acc)[2][2][4][2], const pg8::Unit& u, int wr, int wc, int fr, int fq) const {
    const int row0 = u.pm * 256 + wr * 64 + fr, col0 = u.pn * 128 + wc * 32 + 8 * fq;
#pragma unroll
    for (int ai = 0; ai < 2; ++ai)
#pragma unroll
      for (int m = 0; m < 4; ++m) {
        const int row = row0 + ai * 128 + m * 16;
        const float rs = row_rstd16(ss, row);
        float o[8];
#pragma unroll
        for (int n = 0; n < 2; ++n)
#pragma unroll
          for (int j = 0; j < 4; ++j) { const float g = acc[ai][0][m][n][j] * rs, up = acc[ai][1][m][n][j] * rs; o[n * 4 + j] = g * up * __builtin_amdgcn_rcpf(1.0f + __expf(-g)); }
        u32x4 w; w.x = pkbf(o[0], o[1]); w.y = pkbf(o[2], o[3]); w.z = pkbf(o[4], o[5]); w.w = pkbf(o[6], o[7]);
        *(u32x4*)(O + (size_t)row * DFF + col0) = w;
      }
  }
};
struct EpiResid {
  static constexpr bool PERM = true, AFTER_DRAIN = false;
  const float* Xin32; float* Xout32; bf16_t* XB; float* ss; float scale; int first, last;
  DI void operator()(const f32x4 (&acc)[2][2][4][2], const pg8::Unit& u, int wr, int wc, int fr, int fq) const {
    const int row0 = u.pm * 256 + wr * 64 + fr, col0 = u.pn * 256 + wc * 32 + 8 * fq;
#pragma unroll
    for (int ai = 0; ai < 2; ++ai)
#pragma unroll
      for (int m = 0; m < 4; ++m) {
        const int row = row0 + ai * 128 + m * 16; const size_t off = (size_t)row * DM + col0;
        float sq = 0.f;
#pragma unroll
        for (int bj = 0; bj < 2; ++bj) {
          const size_t o = off + bj * 128;
          f32x4 x0, x1;
          if (first) { x0 = *(const f32x4*)(Xin32 + o); x1 = *(const f32x4*)(Xin32 + o + 4); }
          else { const u32x4 ub = *(const u32x4*)(XB + o); x0[0] = bflo(ub.x); x0[1] = bfhi(ub.x); x0[2] = bflo(ub.y); x0[3] = bfhi(ub.y); x1[0] = bflo(ub.z); x1[1] = bfhi(ub.z); x1[2] = bflo(ub.w); x1[3] = bfhi(ub.w); }
          const f32x4 n0 = x0 + acc[ai][bj][m][0] * scale, n1 = x1 + acc[ai][bj][m][1] * scale;
          if (last) { *(f32x4*)(Xout32 + o) = n0; *(f32x4*)(Xout32 + o + 4) = n1; }
          else { u32x4 w; w.x = pkbf(n0[0], n0[1]); w.y = pkbf(n0[2], n0[3]); w.z = pkbf(n1[0], n1[1]); w.w = pkbf(n1[2], n1[3]); *(u32x4*)(XB + o) = w; }
          sq += ((n0[0] * n0[0] + n0[1] * n0[1]) + (n0[2] * n0[2] + n0[3] * n0[3])) + ((n1[0] * n1[0] + n1[1] * n1[1]) + (n1[2] * n1[2] + n1[3] * n1[3]));
        }
        sq += __shfl_xor(sq, 16); sq += __shfl_xor(sq, 32);
        if (fq == 0 && !last) ss[(size_t)row * 16 + u.pn * 4 + wc] = sq;
      }
  }
};
struct WinOrder {
  pg8::StaticOrder so; int G, c, nkv;
  DI void init(int N_, int G_, int c_, int with_kv) { so.init(MTOK, N_, G_, c_); G = G_; c = c_; nkv = with_kv ? 64 : 0; }
  DI bool next(int i, pg8::Unit& u) const {
    const long L = (long)i * G + c;
    if (L < so.nwg) return so.next(i, u);
    const int j = (int)(L - so.nwg); if (j >= nkv) return false;
    u.pm = 64 + (j >> 3); u.pn = 11 + (j & 7); return true;
  }
  DI void a_ready(const pg8::Unit&) const {}
  DI void done(const pg8::Unit&) const {}
};

struct ConvDesc { const float* W; const float* g; bf16_t* WT; int K, Nsrc, mode, nvalid, item, nblk; };
DI void conv_load(const ConvDesc& d, int lane, f32x4 (&v)[8], float (&gv)[8]) {
  const int kb = d.item / d.nblk, nb = d.item % d.nblk, k0 = 64 * kb, n0 = 32 * nb;
  int sc = n0;
  if (d.mode == 1) { const int pn = n0 >> 8, c = n0 & 255; sc = (c < 128) ? (128 * pn + c) : (2816 + 128 * pn + (c - 128)); }
  const bool valid = n0 < d.nvalid;
  const int kr = lane >> 3, n4 = (lane & 7) * 4;
#pragma unroll
  for (int i = 0; i < 8; ++i) {
    const int kk = 8 * i + kr;
    v[i] = valid ? *(const f32x4*)(d.W + (size_t)(k0 + kk) * d.Nsrc + sc + n4) : (f32x4){0.f, 0.f, 0.f, 0.f};
    gv[i] = d.g ? d.g[k0 + kk] : 1.0f;
  }
}
DI void conv_finish(const ConvDesc& d, const f32x4 (&v)[8], const float (&gv)[8], LAS float* scr, int lane) {
  const int kb = d.item / d.nblk, nb = d.item % d.nblk, k0 = 64 * kb, n0 = 32 * nb;
  const int kr = lane >> 3, n4 = (lane & 7) * 4;
#pragma unroll
  for (int i = 0; i < 8; ++i) {
    const int kk = 8 * i + kr; LAS float* dd = scr + kk * 33 + n4;
    dd[0] = v[i][0] * gv[i]; dd[1] = v[i][1] * gv[i]; dd[2] = v[i][2] * gv[i]; dd[3] = v[i][3] * gv[i];
  }
  LDS_WAIT();
  const int c = lane & 7;
#pragma unroll
  for (int j = 0; j < 4; ++j) {
    const int n = (lane >> 3) + 8 * j; const LAS float* s = scr + (8 * c) * 33 + n;
    u32x4 o; o.x = pkbf(s[0 * 33], s[1 * 33]); o.y = pkbf(s[2 * 33], s[3 * 33]); o.z = pkbf(s[4 * 33], s[5 * 33]); o.w = pkbf(s[6 * 33], s[7 * 33]);
    *(u32x4*)(d.WT + (size_t)(n0 + n) * d.K + k0 + 8 * c) = o;
  }
  LDS_WAIT();
}
DI ConvDesc conv_desc(KP p, int l, int it) {
  unsigned char* W = p->ws + WS_W;
  constexpr int I_WI = 16 * 176, I_WO = 44 * 32, I_WIN = 16 * 88, I_WKV = 16 * 64, I_SQ = 16 * 32;
  int r = it;
  if (r < I_WI) return ConvDesc{p->in[3] + (size_t)l * 1024 * 5632, p->in[2] + l * 1024, (bf16_t*)(W + W_WI1), 1024, 5632, 1, 5632, r, 176}; r -= I_WI;
  if (r < I_WO) return ConvDesc{p->in[4] + (size_t)l * 2816 * 1024, nullptr, (bf16_t*)(W + W_WO1), 2816, 1024, 0, 1024, r, 32}; r -= I_WO;
  if (r < I_WIN) return ConvDesc{p->in[6] + (size_t)l * 1024 * 2688, p->in[5] + l * 1024, (bf16_t*)(W + W_WIN), 1024, 2688, 0, 2688, r, 88}; r -= I_WIN;
  if (r < I_WKV) return ConvDesc{p->in[30] + (size_t)l * 1024 * 2048, p->in[28] + l * 1024, (bf16_t*)(W + W_WKV), 1024, 2048, 0, 2048, r, 64}; r -= I_WKV;
  if (r < I_SQ) return ConvDesc{p->in[7] + (size_t)l * 1024 * 1024, nullptr, (bf16_t*)(W + W_WOUT), 1024, 1024, 0, 1024, r, 32}; r -= I_SQ;
  if (r < I_SQ) return ConvDesc{p->in[29] + (size_t)l * 1024 * 1024, p->in[27] + l * 1024, (bf16_t*)(W + W_WQ), 1024, 1024, 0, 1024, r, 32}; r -= I_SQ;
  if (r < I_SQ) return ConvDesc{p->in[31] + (size_t)l * 1024 * 1024, nullptr, (bf16_t*)(W + W_WOX), 1024, 1024, 0, 1024, r, 32}; r -= I_SQ;
  if (r < I_WI) return ConvDesc{p->in[35] + (size_t)l * 1024 * 5632, p->in[34] + l * 1024, (bf16_t*)(W + W_WI2), 1024, 5632, 1, 5632, r, 176}; r -= I_WI;
  return ConvDesc{p->in[36] + (size_t)l * 2816 * 1024, nullptr, (bf16_t*)(W + W_WO2), 2816, 1024, 0, 1024, r, 32};
}
DI void phase_conv(KP p, int l, LAS unsigned char* lds, int gw, int NGW, int wave, int lane, int it_lo, int it_hi) {
  LAS float* scr = (LAS float*)(lds + wave * 8448);
  int it = it_lo + gw;
  if (it >= it_hi) return;
  ConvDesc cur = conv_desc(p, l, it);
  f32x4 v[8]; float gv[8];
  conv_load(cur, lane, v, gv);
  for (; it < it_hi; it += NGW) {
    const bool more = it + NGW < it_hi;
    ConvDesc nxt = cur; f32x4 v2[8]; float gv2[8];
    if (more) { nxt = conv_desc(p, l, it + NGW); conv_load(nxt, lane, v2, gv2); }
    __builtin_amdgcn_sched_barrier(0);
    conv_finish(cur, v, gv, scr, lane);
    if (more) { cur = nxt;
#pragma unroll
      for (int i = 0; i < 8; ++i) { v[i] = v2[i]; gv[i] = gv2[i]; } }
  }
}
DI void phase_init(KP p, int gw, int NGW, int lane, int row_lo) {
  bf16_t* XB = (bf16_t*)(p->ws + WS_XB); float* SS = (float*)(p->ws + WS_SS); float* RSM = (float*)(p->ws + WS_RSM);
  auto row_src = [&](int m) { return m < MTOK ? p->in[0] + (size_t)m * DM : p->in[1] + (size_t)(m - MTOK) * DM; };
  f32x4 nx[4];
  { const int m0 = row_lo + gw; if (m0 < MTOK + 2048) {
#pragma unroll
      for (int j = 0; j < 4; ++j) nx[j] = ((const f32x4*)row_src(m0))[lane + 64 * j]; } }
  for (int m = row_lo + gw; m < MTOK + 2048; m += NGW) {
    const bool isx = m < MTOK;
    f32x4 v[4]; float s = 0.f;
#pragma unroll
    for (int j = 0; j < 4; ++j) v[j] = nx[j];
    { const int mn = (m + NGW < MTOK + 2048) ? m + NGW : m;
#pragma unroll
      for (int j = 0; j < 4; ++j) nx[j] = ((const f32x4*)row_src(mn))[lane + 64 * j]; }
    __builtin_amdgcn_sched_barrier(0);
#pragma unroll
    for (int j = 0; j < 4; ++j) s += (v[j][0] * v[j][0] + v[j][1] * v[j][1]) + (v[j][2] * v[j][2] + v[j][3] * v[j][3]);
    s = wave_sum(s);
    u32x2* o8 = (u32x2*)(XB + (size_t)m * DM);
#pragma unroll
    for (int j = 0; j < 4; ++j) { u32x2 w; w.x = pkbf(v[j][0], v[j][1]); w.y = pkbf(v[j][2], v[j][3]); o8[lane + 64 * j] = w; }
    if (isx) {
      if (lane < 16) SS[(size_t)m * 16 + lane] = lane == 0 ? s : 0.f;
    } else if (lane == 0) RSM[m - MTOK] = __builtin_amdgcn_rsqf(s * (1.0f / 1024.0f) + RMS_EPS);
  }
}

DI void unpack8(const u32x4 u, float (&f)[8]) { f[0] = bflo(u.x); f[1] = bfhi(u.x); f[2] = bflo(u.y); f[3] = bfhi(u.y); f[4] = bflo(u.z); f[5] = bfhi(u.z); f[6] = bflo(u.w); f[7] = bfhi(u.w); }
DI void phase_prep_rwkv(KP p, int l, int hf, LAS unsigned char* lds, int tid, int bid, int G) {
  LAS float* ps = (LAS float*)lds;
  LAS float* vd = ps + 16 * 1280;
  LAS unsigned short* twb = (LAS unsigned short*)(vd + 16 * 32);
  LAS unsigned short* adb = twb + 16 * 40;
  LAS unsigned short* vdb = adb + 16 * 40;
  LAS _Float16* vdT = (LAS _Float16*)(vdb + 16 * 40);
  const bf16_t* P = (const bf16_t*)(p->ws + WS_U);
  _Float16* VF = (_Float16*)(p->ws + WS_VF); float* RKB = (float*)(p->ws + WS_RKB);
  const float* mu = p->in[8] + l * APROJ; const float* w0 = p->in[9] + l * AW; const float* w_up = p->in[10] + l * 32 * AW;
  const float* a0 = p->in[11] + l * AW; const float* a_up = p->in[12] + l * 32 * AW;
  const float* k_k = p->in[14] + l * AW; const float* k_a = p->in[15] + l * AW; const float* r_k = p->in[16] + l * AW;
  const float* v0 = p->in[19]; const float* v_down = p->in[20]; const float* v_up = p->in[21];
  const int lane = tid & 63, wv = tid >> 6, l15 = lane & 15, q4 = lane >> 4, hd = wv < 6 ? wv : 5;
  bf16x8 wf[4], af[4], vf[4]; float w0c[4], a0c[4], v0c[4], kkc[4], kac[4], rkc[4];
#pragma unroll
  for (int dt = 0; dt < 4; ++dt) {
    const int c = hd * 64 + dt * 16 + l15;
    const float* wp = w_up + (size_t)(8 * q4) * AW + c; const float* ap = a_up + (size_t)(8 * q4) * AW + c; const float* vp_ = v_up + (size_t)(8 * q4) * AW + c;
    u32x4 w; w.x = pkbf(wp[0], wp[AW]); w.y = pkbf(wp[2 * AW], wp[3 * AW]); w.z = pkbf(wp[4 * AW], wp[5 * AW]); w.w = pkbf(wp[6 * AW], wp[7 * AW]); wf[dt] = __builtin_bit_cast(bf16x8, w);
    u32x4 x; x.x = pkbf(ap[0], ap[AW]); x.y = pkbf(ap[2 * AW], ap[3 * AW]); x.z = pkbf(ap[4 * AW], ap[5 * AW]); x.w = pkbf(ap[6 * AW], ap[7 * AW]); af[dt] = __builtin_bit_cast(bf16x8, x);
    u32x4 y = (u32x4){0u, 0u, 0u, 0u};
    if (l == 1) { y.x = pkbf(vp_[0], vp_[AW]); y.y = pkbf(vp_[2 * AW], vp_[3 * AW]); y.z = pkbf(vp_[4 * AW], vp_[5 * AW]); y.w = pkbf(vp_[6 * AW], vp_[7 * AW]); }
    vf[dt] = __builtin_bit_cast(bf16x8, y);
    w0c[dt] = w0[c]; a0c[dt] = a0[c]; v0c[dt] = (l == 1) ? v0[c] : 0.f; kkc[dt] = k_k[c]; kac[dt] = k_a[c]; rkc[dt] = r_k[c];
  }
  if (l == 1) { for (int e = tid; e < 384 * 32; e += 512) { const int cc = e >> 5, j = e & 31; vdT[j * 392 + cc] = (_Float16)v_down[e]; } }
  for (int tile = bid; tile < 1024; tile += G) {
    const int b = tile >> 7, t0 = (tile & 127) * 16, tok0 = b * TSEQ + t0;
    _Float16* S6 = (_Float16*)s6_block(p, b * 6 + hd);
    for (int e = tid; e < 2560; e += 512) {
      const int i = e / 160, c8 = (e % 160) * 8;
      const size_t r = (size_t)(tok0 + i) * PW + c8;
      const u32x4 cur = *(const u32x4*)(P + r);
      u32x4 prv = (u32x4){0u, 0u, 0u, 0u};
      if (t0 + i > 0) prv = *(const u32x4*)(P + r - PW);
      float pc[8], pp[8]; unpack8(cur, pc); unpack8(prv, pp);
      const f32x4 m0 = *(const f32x4*)(mu + c8), m1 = *(const f32x4*)(mu + c8 + 4);
      f32x4 o0, o1;
#pragma unroll
      for (int j = 0; j < 4; ++j) { o0[j] = pc[j] + m0[j] * (pp[j] - pc[j]); o1[j] = pc[4 + j] + m1[j] * (pp[4 + j] - pc[4 + j]); }
      *(LAS f32x4*)(ps + i * 1280 + c8) = o0; *(LAS f32x4*)(ps + i * 1280 + c8 + 4) = o1;
    }
    _Float16 vfv[16];
#pragma unroll
    for (int i = 0; i < 4; ++i)
#pragma unroll
      for (int dt = 0; dt < 4; ++dt) vfv[i * 4 + dt] = (l == 1) ? VF[(size_t)(tok0 + 4 * q4 + i) * AW + hd * 64 + dt * 16 + l15] : (_Float16)0.f;
    __syncthreads();
    {
      const int i = tid >> 5, j = tid & 31;
      { const float xv = ps[i * 1280 + 1152 + j]; twb[i * 40 + j] = (unsigned short)(pkbf(1.0f - 2.0f * __builtin_amdgcn_rcpf(1.0f + __expf(2.0f * xv)), 0.f) & 0xffffu); }
      adb[i * 40 + j] = (unsigned short)(pkbf(ps[i * 1280 + 1184 + j], 0.f) & 0xffffu);
      if (l == 1) {
        float s0 = 0.f, s1 = 0.f;
#pragma unroll 4
        for (int cc = 0; cc < 384; cc += 8) {
          const f32x4 pa = *(const LAS f32x4*)(ps + i * 1280 + 768 + cc), pb = *(const LAS f32x4*)(ps + i * 1280 + 768 + cc + 4);
          const h8_t hv = *(const LAS h8_t*)(vdT + j * 392 + cc);
          s0 += (pa[0] * (float)hv[0] + pa[1] * (float)hv[1]) + (pa[2] * (float)hv[2] + pa[3] * (float)hv[3]);
          s1 += (pb[0] * (float)hv[4] + pb[1] * (float)hv[5]) + (pb[2] * (float)hv[6] + pb[3] * (float)hv[7]);
        }
        vdb[i * 40 + j] = (unsigned short)(pkbf(s0 + s1, 0.f) & 0xffffu);
      }
    }
    __syncthreads();
    if (wv < 6) {
      const bf16x8 atw = *(const LAS bf16x8*)(twb + l15 * 40 + 8 * q4), aad = *(const LAS bf16x8*)(adb + l15 * 40 + 8 * q4);
      bf16x8 avd = atw; if (l == 1) avd = *(const LAS bf16x8*)(vdb + l15 * 40 + 8 * q4);
      f32x4 accw[4], acca[4], accv[4];
#pragma unroll
      for (int dt = 0; dt < 4; ++dt) {
        const f32x4 z4 = (f32x4){0.f, 0.f, 0.f, 0.f};
        accw[dt] = __builtin_amdgcn_mfma_f32_16x16x32_bf16(atw, wf[dt], z4, 0, 0, 0);
        acca[dt] = __builtin_amdgcn_mfma_f32_16x16x32_bf16(aad, af[dt], z4, 0, 0, 0);
        accv[dt] = z4; if (l == 1) accv[dt] = __builtin_amdgcn_mfma_f32_16x16x32_bf16(avd, vf[dt], z4, 0, 0, 0);
      }
#pragma unroll
      for (int i = 0; i < 4; ++i) {
        const int ti = 4 * q4 + i, tok = tok0 + ti, t = t0 + ti;
        float kkr[4], kp[4], rr[4], vp[4], aa4[4], om4[4]; float nsum = 0.f, rksum = 0.f;
#pragma unroll
        for (int dt = 0; dt < 4; ++dt) {
          const int c = hd * 64 + dt * 16 + l15;
          const float aw = w0c[dt] + accw[dt][i], aa = a0c[dt] + acca[dt][i], av = v0c[dt] + accv[dt][i];
          const float z = -aw; const float sp = fmaxf(z, 0.f) + __logf(1.0f + __expf(-fabsf(z)));
          const float e = __expf(-sp - 0.5f), xm = -e;
          float om = 1.0f / 40320.0f; om = om * xm + 1.0f / 5040.0f; om = om * xm + 1.0f / 720.0f; om = om * xm + 1.0f / 120.0f; om = om * xm + 1.0f / 24.0f; om = om * xm + 1.0f / 6.0f; om = om * xm + 0.5f; om = om * xm + 1.0f; om = om * xm;
          const float a = sigmoidf_(aa);
          const float r = ps[ti * 1280 + c], k = ps[ti * 1280 + 384 + c], v = ps[ti * 1280 + 768 + c];
          float vpp = v;
          if (l == 0) VF[(size_t)tok * AW + c] = (_Float16)v;
          else { const float vfl = (float)vfv[i * 4 + dt]; vpp = v + (vfl - v) * sigmoidf_(av); }
          kkr[dt] = k * kkc[dt]; nsum += kkr[dt] * kkr[dt];
          kp[dt] = k * (1.0f + (a - 1.0f) * kac[dt]); rksum += r * kp[dt] * rkc[dt];
          rr[dt] = r; vp[dt] = vpp; aa4[dt] = a; om4[dt] = om;
        }
        nsum = allreduce16(nsum); rksum = allreduce16(rksum);
        const float inv = __builtin_amdgcn_rcpf(fmaxf(__builtin_amdgcn_sqrtf(nsum), 1e-12f));
        const size_t base = ((size_t)t * 6) * 64 + l15;
#pragma unroll
        for (int dt = 0; dt < 4; ++dt) {
          const float kk = kkr[dt] * inv; const size_t o = base + dt * 16;
          S6[o] = (_Float16)rr[dt]; S6[o + 64] = (_Float16)kp[dt]; S6[o + 128] = (_Float16)vp[dt]; S6[o + 192] = (_Float16)kk; S6[o + 256] = (_Float16)(-(kk * aa4[dt])); S6[o + 320] = (_Float16)om4[dt];
        }
        if (l15 == 0) RKB[(size_t)(b * 6 + hd) * TSEQ + t] = rksum;
      }
    }
    __syncthreads();
  }
}

DI void transpose64(const bf16_t* src, size_t spitch, bf16_t* dst, size_t dpitch, LAS unsigned short* scr, int lane) {
#pragma unroll
  for (int it = 0; it < 8; ++it) {
    const int row = it * 8 + (lane >> 3), c8 = (lane & 7) * 8;
    const u32x4 v = *(const u32x4*)(src + (size_t)row * spitch + c8);
    LAS unsigned* d = (LAS unsigned*)(scr + row * 66 + c8);
    d[0] = v.x; d[1] = v.y; d[2] = v.z; d[3] = v.w;
  }
  LDS_WAIT();
#pragma unroll
  for (int t8 = 0; t8 < 8; ++t8) {
    unsigned w[4];
#pragma unroll
    for (int j = 0; j < 4; ++j) { const unsigned lo = scr[(t8 * 8 + 2 * j) * 66 + lane], hi = scr[(t8 * 8 + 2 * j + 1) * 66 + lane]; w[j] = lo | (hi << 16); }
    u32x4 o; o.x = w[0]; o.y = w[1]; o.z = w[2]; o.w = w[3];
    *(u32x4*)(dst + (size_t)lane * dpitch + t8 * 8) = o;
  }
  LDS_WAIT();
}
template <int PART> DI void phase_attn_prep(KP p, int l, LAS unsigned char* lds, int gw, int NGW, int wave, int lane) {
  bf16_t* P = (bf16_t*)(p->ws + WS_U);
  LAS unsigned short* scr = (LAS unsigned short*)(lds + wave * 8448);
  if constexpr (PART == 0) {
    const float* qg = p->in[22] + l * 64; const float* kg = p->in[23] + l * 64;
    const int cl = lane < 48 ? lane : 47, d0 = (cl & 7) * 8;
    float gg[8];
#pragma unroll
    for (int j = 0; j < 8; ++j) gg[j] = qg[d0 + j] * kg[d0 + j];
    for (int tok0 = gw; tok0 < MTOK; tok0 += 8 * NGW) {
      u32x4 rows[8];
#pragma unroll
      for (int q = 0; q < 8; ++q) { const int tok = tok0 + q * NGW; rows[q] = (tok < MTOK) ? *(const u32x4*)(P + (size_t)tok * PW + PK + cl * 8) : (u32x4){0u, 0u, 0u, 0u}; }
#pragma unroll
      for (int q = 0; q < 8; ++q) {
        const int tok = tok0 + q * NGW;
        float f[8]; unpack8(rows[q], f);
        float s = 0.f;
#pragma unroll
        for (int j = 0; j < 8; ++j) s += f[j] * f[j];
        s += __shfl_xor(s, 1); s += __shfl_xor(s, 2); s += __shfl_xor(s, 4);
        const float rs = __builtin_amdgcn_rsqf(s * (1.0f / 64.0f) + RMS_EPS);
        u32x4 o; o.x = pkbf(f[0] * rs * gg[0], f[1] * rs * gg[1]); o.y = pkbf(f[2] * rs * gg[2], f[3] * rs * gg[3]); o.z = pkbf(f[4] * rs * gg[4], f[5] * rs * gg[5]); o.w = pkbf(f[6] * rs * gg[6], f[7] * rs * gg[7]);
        if (lane < 48 && tok < MTOK) *(u32x4*)(P + (size_t)tok * PW + PK + cl * 8) = o;
      }
    }
  }
  if constexpr (PART == 0) {
    bf16_t* VTB = (bf16_t*)(p->ws + WS_VTB);
    for (int it = gw; it < 8 * 6 * 32; it += NGW) {
      const int tb = it & 31, h = (it >> 5) % 6, b = it / 192;
      transpose64(P + (size_t)(b * TSEQ + tb * 64) * PW + PV + h * 64, PW, VTB + (size_t)((b * 6 + h) * 64) * TSEQ + tb * 64, TSEQ, scr, lane);
    }
  }
  if constexpr (PART == 1) {
    const bf16_t* KVC = (const bf16_t*)(p->ws + WS_KVC); bf16_t* KNC = (bf16_t*)(p->ws + WS_KNC); bf16_t* VTC = (bf16_t*)(p->ws + WS_VTC);
    const float* qg = p->in[32] + l * 256; const float* kg = p->in[33] + l * 256;
    for (int it = gw; it < 2048 * 4; it += NGW) {
      const int row = it >> 2, h = it & 3;
      const u32x2 u = *(const u32x2*)(KVC + (size_t)row * 2048 + h * 256 + lane * 4);
      const float f0 = bflo(u.x), f1 = bfhi(u.x), f2 = bflo(u.y), f3 = bfhi(u.y);
      const float s = wave_sum((f0 * f0 + f1 * f1) + (f2 * f2 + f3 * f3));
      const float rs = __builtin_amdgcn_rsqf(s * (1.0f / 256.0f) + RMS_EPS);
      const f32x4 a = *(const f32x4*)(qg + lane * 4), bb = *(const f32x4*)(kg + lane * 4);
      u32x2 o; o.x = pkbf(f0 * rs * a[0] * bb[0], f1 * rs * a[1] * bb[1]); o.y = pkbf(f2 * rs * a[2] * bb[2], f3 * rs * a[3] * bb[3]);
      *(u32x2*)(KNC + (size_t)row * 1024 + h * 256 + lane * 4) = o;
    }
    for (int it = gw; it < 8 * 4 * 16; it += NGW) {
      const int mt = it & 3, dt = (it >> 2) & 3, h = (it >> 4) & 3, b = it >> 6;
      transpose64(KVC + (size_t)(b * 256 + mt * 64) * 2048 + 1024 + h * 256 + dt * 64, 2048, VTC + (size_t)((b * 4 + h) * 256 + dt * 64) * 256 + mt * 64, 256, scr, lane);
    }
  }
}

constexpr int SCAN_STEP_B = 1152, SCAN_CHUNK_B = 32 * SCAN_STEP_B;
DI void scan_issue(const unsigned char* src, int lt, u32x4 (&v)[6]) {
#pragma unroll
  for (int q = 0; q < 6; ++q) v[q] = *(const u32x4*)(src + (size_t)(q * 256 + lt) * 16);
}
DI void scan_write(const u32x4 (&v)[6], LAS unsigned char* dst, int lt) {
#pragma unroll
  for (int q = 0; q < 6; ++q) {
    const int e = (q * 256 + lt) * 8, t = e / 384, rem = e - t * 384, X = rem >> 6, c = rem & 63;
    LAS unsigned char* d = dst + t * SCAN_STEP_B;
    if (X == 1 || X == 4 || X == 5) {
      const h8_t hv = __builtin_bit_cast(h8_t, v[q]);
      f32x4 a, b; a[0] = (float)hv[0]; a[1] = (float)hv[1]; a[2] = (float)hv[2]; a[3] = (float)hv[3]; b[0] = (float)hv[4]; b[1] = (float)hv[5]; b[2] = (float)hv[6]; b[3] = (float)hv[7];
      LAS unsigned char* dd = d + (X == 1 ? 0 : X == 4 ? 256 : 512) + c * 4;
      *(LAS f32x4*)dd = a; *(LAS f32x4*)(dd + 16) = b;
    } else {
      *(LAS u32x4*)(d + (X == 0 ? 768 : X == 3 ? 896 : 1024) + c * 2) = v[q];
    }
  }
}
DI void phase_scan(KP p, int hf, LAS unsigned char* lds, int tid, int bid) {
  if (bid >= 192) return;
  const int bh = bid >> 2, rg = bid & 3, b = bh / 6, h = bh % 6;
  const int wave = tid >> 6, lane = tid & 63;
  LAS unsigned char* buf = lds;
  const unsigned char* S6 = s6_block(p, bh);
  const float* RKB = (const float*)(p->ws + WS_RKB) + (size_t)bh * TSEQ;
  _Float16* YH = (_Float16*)(p->ws + WS_YH); _Float16* BON = (_Float16*)(p->ws + WS_BON);
  bool is_comp = wave < 4; int widx = wave & 3;
  {
    LAS int* roles = (LAS int*)(lds + 2 * SCAN_CHUNK_B);
    const int simd = (int)__builtin_amdgcn_s_getreg((1 << 11) | (4 << 6) | 4);
    if (lane == 0) roles[wave] = simd;
    __syncthreads();
    int sid[8], rk[8], nfirst = 0;
#pragma unroll
    for (int w = 0; w < 8; ++w) sid[w] = roles[w];
#pragma unroll
    for (int w = 0; w < 8; ++w) { int r = 0;
#pragma unroll
      for (int u = 0; u < 8; ++u) if (u < w && sid[u] == sid[w]) ++r;
      rk[w] = r; nfirst += (r == 0); }
    if (nfirst == 4) {
      int myr = 0, ci = 0, li = 0;
#pragma unroll
      for (int w = 0; w < 8; ++w) { if (w == wave) myr = rk[w]; if (w < wave) { ci += (rk[w] == 0); li += (rk[w] != 0); } }
      is_comp = (myr == 0); widx = is_comp ? ci : li;
    }
    __syncthreads();
  }
  const int kq = lane & 15, v = 16 * rg + 4 * widx + (lane >> 4);
  f32x2 S01 = {0.f, 0.f}, S23 = {0.f, 0.f};
  const int lt = widx * 64 + lane;
  u32x4 R[6]; unsigned bvv = 0u; float brk = 0.f;
  const int bt = lt >> 3, br2 = (lt & 7) * 2;
  if (!is_comp) {
    scan_issue(S6, lt, R); scan_write(R, buf, lt); scan_issue(S6 + 24576, lt, R);
    bvv = *(const unsigned*)(S6 + ((size_t)(bt * 6 + 2) * 64 + 16 * rg + br2) * 2); brk = RKB[bt];
  }

  __syncthreads();
  if (is_comp) __builtin_amdgcn_s_setprio(3);
  const size_t obase = (size_t)(b * TSEQ) * AW + h * 64;
  h4_t rp4 = {(_Float16)0.f, (_Float16)0.f, (_Float16)0.f, (_Float16)0.f}; float ykeep = 0.f;
  for (int ch = 0; ch < 64; ++ch) {
    if (!is_comp) {
      if (ch + 1 < 64) scan_write(R, buf + ((ch + 1) & 1) * SCAN_CHUNK_B, lt);
      if (ch + 2 < 64) scan_issue(S6 + (size_t)(ch + 2) * 24576, lt, R);
      {
        const h4_t hv = __builtin_bit_cast(h4_t, (u32x2){bvv, 0u});
        typedef _Float16 h2_t __attribute__((ext_vector_type(2)));
        h2_t o; o[0] = (_Float16)(brk * (float)hv[0]); o[1] = (_Float16)(brk * (float)hv[1]);
        *(h2_t*)(BON + obase + (size_t)(ch * 32 + bt) * AW + 16 * rg + br2) = o;
        if (ch + 1 < 64) { bvv = *(const unsigned*)(S6 + (size_t)(ch + 1) * 24576 + ((size_t)(bt * 6 + 2) * 64 + 16 * rg + br2) * 2); brk = RKB[(ch + 1) * 32 + bt]; }
      }
    } else {
      const LAS unsigned char* cb = buf + (ch & 1) * SCAN_CHUNK_B;
      f32x4 k4 = *(const LAS f32x4*)(cb + kq * 16), nb4 = *(const LAS f32x4*)(cb + 256 + kq * 16), nom4 = *(const LAS f32x4*)(cb + 512 + kq * 16);
      h4_t r4 = *(const LAS h4_t*)(cb + 768 + kq * 8), kk4 = *(const LAS h4_t*)(cb + 896 + kq * 8);
      _Float16 vh = *(const LAS _Float16*)(cb + 1024 + v * 2);
      f32x4 k4n = *(const LAS f32x4*)(cb + SCAN_STEP_B + kq * 16), nb4n = *(const LAS f32x4*)(cb + SCAN_STEP_B + 256 + kq * 16), nom4n = *(const LAS f32x4*)(cb + SCAN_STEP_B + 512 + kq * 16);
      h4_t r4n = *(const LAS h4_t*)(cb + SCAN_STEP_B + 768 + kq * 8), kk4n = *(const LAS h4_t*)(cb + SCAN_STEP_B + 896 + kq * 8);
      _Float16 vhn = *(const LAS _Float16*)(cb + SCAN_STEP_B + 1024 + v * 2);
#pragma unroll 8
      for (int s = 0; s < 32; ++s) {
        const LAS unsigned char* sb = cb + (s + 2 < 32 ? s + 2 : 31) * SCAN_STEP_B;
        const f32x4 k4m = *(const LAS f32x4*)(sb + kq * 16), nb4m = *(const LAS f32x4*)(sb + 256 + kq * 16), nom4m = *(const LAS f32x4*)(sb + 512 + kq * 16);
        const h4_t r4m = *(const LAS h4_t*)(sb + 768 + kq * 8), kk4m = *(const LAS h4_t*)(sb + 896 + kq * 8);
        const _Float16 vhm = *(const LAS _Float16*)(sb + 1024 + v * 2);
        __builtin_amdgcn_sched_barrier(0);
        const float vv = (float)vh;
        float sa = __builtin_fmaf(S01[0], (float)kk4[0], 0.f), y = __builtin_fmaf(S01[0], (float)rp4[0], 0.f);
        sa = __builtin_fmaf(S01[1], (float)kk4[1], sa); y = __builtin_fmaf(S01[1], (float)rp4[1], y);
        sa = __builtin_fmaf(S23[0], (float)kk4[2], sa); y = __builtin_fmaf(S23[0], (float)rp4[2], y);
        sa = __builtin_fmaf(S23[1], (float)kk4[3], sa); y = __builtin_fmaf(S23[1], (float)rp4[3], y);
        float t0 = vfma(vv, k4[0], S01[0]), t1 = vfma(vv, k4[1], S01[1]), t2 = vfma(vv, k4[2], S23[0]), t3 = vfma(vv, k4[3], S23[1]);
        sa = dpp_addx<0xB1>(sa); y = dpp_addx<0xB1>(y); sa = dpp_addx<0x4E>(sa); y = dpp_addx<0x4E>(y);
        sa = dpp_addx<0x141>(sa); y = dpp_addx<0x141>(y); sa = dpp_addx<0x140>(sa); y = dpp_addx<0x140>(y);
        t0 = vfma(sa, nb4[0], t0); t1 = vfma(sa, nb4[1], t1); t2 = vfma(sa, nb4[2], t2); t3 = vfma(sa, nb4[3], t3);
        S01[0] = vfma(nom4[0], S01[0], t0); S01[1] = vfma(nom4[1], S01[1], t1); S23[0] = vfma(nom4[2], S23[0], t2); S23[1] = vfma(nom4[3], S23[1], t3);
        ykeep = (kq == ((s + 15) & 15)) ? y : ykeep;
        if ((s & 15) == 0 && (ch | s) != 0) YH[obase + (size_t)(ch * 32 + s - 16 + kq) * AW + v] = (_Float16)ykeep;
        rp4 = r4; k4 = k4n; nb4 = nb4n; nom4 = nom4n; r4 = r4n; kk4 = kk4n; vh = vhn;
        k4n = k4m; nb4n = nb4m; nom4n = nom4m; r4n = r4m; kk4n = kk4m; vhn = vhm;
        __builtin_amdgcn_sched_barrier(0);
      }
    }
    asm volatile("s_waitcnt lgkmcnt(0)" ::: "memory"); __builtin_amdgcn_s_barrier(); asm volatile("" ::: "memory");
  }
  __builtin_amdgcn_s_setprio(0);
  if (is_comp) {
    float y = S01[0] * (float)rp4[0]; y = __builtin_fmaf(S01[1], (float)rp4[1], y); y = __builtin_fmaf(S23[0], (float)rp4[2], y); y = __builtin_fmaf(S23[1], (float)rp4[3], y);
    y = allreduce16(y);
    ykeep = (kq == 15) ? y : ykeep;
    YH[obase + (size_t)(TSEQ - 16 + kq) * AW + v] = (_Float16)ykeep;
  }

}

#define MFMA32(a, b, c) __builtin_amdgcn_mfma_f32_32x32x16_bf16((a), (b), (c), 0, 0, 0)
constexpr float LOG2E = 1.4426950408889634f;
DI int crow(int r, int hi) { return (r & 3) + 8 * (r >> 2) + 4 * hi; }
DI bf16x8 pack8(const f32x16& x, int s) {
  u32x4 pk; pk.x = pkbf(x[8 * s], x[8 * s + 1]); pk.y = pkbf(x[8 * s + 2], x[8 * s + 3]); pk.z = pkbf(x[8 * s + 4], x[8 * s + 5]); pk.w = pkbf(x[8 * s + 6], x[8 * s + 7]);
  return __builtin_bit_cast(bf16x8, pk);
}
DI bf16x8 ld2x4(const bf16_t* p0) {
  const u32x2 a = *(const u32x2*)p0, b = *(const u32x2*)(p0 + 8);
  u32x4 r; r.x = a.x; r.y = a.y; r.z = b.x; r.w = b.y; return __builtin_bit_cast(bf16x8, r);
}
DI float sumsq8(const bf16x8 v) { const u32x4 u = __builtin_bit_cast(u32x4, v); float f[8]; unpack8(u, f); float s = 0.f;
#pragma unroll
  for (int j = 0; j < 8; ++j) s += f[j] * f[j];
  return s; }
DI void chunk_attn_task(const bf16_t* P, const bf16_t* VTB, bf16_t* Y, const LAS float* biasl, int task, int lane) {
  const int n = task & 31, bhh = task >> 5, h = bhh % 6, b = bhh / 6;
  const int c = lane & 31, hh = lane >> 5;
  bf16x8 qb[2][4]; float sc[2], m[2], lsum[2]; f32x16 o0[2], o1[2];
#pragma unroll
  for (int qh = 0; qh < 2; ++qh) {
    const int qpos = n * 64 + qh * 32 + c;
    const bf16_t* qp = P + (size_t)(b * TSEQ + qpos) * PW + PQ + h * 64 + 8 * hh;
    float sq = 0.f;
#pragma unroll
    for (int s = 0; s < 4; ++s) { qb[qh][s] = *(const bf16x8*)(qp + 16 * s); sq += sumsq8(qb[qh][s]); }
    sq += __shfl_xor(sq, 32);
    sc[qh] = __builtin_amdgcn_rsqf(sq * (1.0f / 64.0f) + RMS_EPS) * 0.125f * LOG2E;
    m[qh] = -1e30f; lsum[qh] = 0.f;
#pragma unroll
    for (int i = 0; i < 16; ++i) { o0[qh][i] = 0.f; o1[qh][i] = 0.f; }
  }
  const int kt0 = (n > 8 ? n - 8 : 0) * 2, kt1 = (n + 1) * 2;
  const bf16_t* Kb = P + (size_t)(b * TSEQ + c) * PW + PK + h * 64 + 8 * hh;
  const bf16_t* Vt = VTB + ((size_t)(b * 6 + h) * 64 + c) * TSEQ + 4 * hh;
  const LAS float* bias = biasl + h * 320;
  bf16x8 ka[4], va[2][2];
#pragma unroll
  for (int s = 0; s < 4; ++s) ka[s] = *(const bf16x8*)(Kb + (size_t)(kt0 * 32) * PW + 16 * s);
#pragma unroll
  for (int dt = 0; dt < 2; ++dt)
#pragma unroll
    for (int s2 = 0; s2 < 2; ++s2) va[dt][s2] = ld2x4(Vt + (size_t)dt * 32 * TSEQ + kt0 * 32 + 16 * s2);
#pragma unroll 1
  for (int kt = kt0; kt < kt1; ++kt) {
    const int key0 = kt * 32, keyn = (kt + 1 < kt1 ? kt + 1 : kt) * 32;
    bf16x8 kan[4], van[2][2];
#pragma unroll
    for (int s = 0; s < 4; ++s) kan[s] = *(const bf16x8*)(Kb + (size_t)keyn * PW + 16 * s);
#pragma unroll
    for (int dt = 0; dt < 2; ++dt)
#pragma unroll
      for (int s2 = 0; s2 < 2; ++s2) van[dt][s2] = ld2x4(Vt + (size_t)dt * 32 * TSEQ + keyn + 16 * s2);
    __builtin_amdgcn_sched_barrier(0);
#pragma unroll
    for (int qh = 0; qh < 2; ++qh) {
      const int qpos = n * 64 + qh * 32 + c;
      f32x16 st;
#pragma unroll
      for (int i = 0; i < 16; ++i) st[i] = 0.f;
#pragma unroll
      for (int s = 0; s < 4; ++s) st = MFMA32(ka[s], qb[qh][s], st);
      float tmax = -1e30f;
      const int qlo = n * 64 + qh * 32;
      if (qlo - (key0 + 31) >= 256) {
        const float bc = bias[319];
#pragma unroll
        for (int i = 0; i < 16; ++i) { st[i] = __builtin_fmaf(st[i], sc[qh], bc); tmax = fmaxf(tmax, st[i]); }
      } else if (qlo + 31 - key0 <= 256) {
        const LAS float* bp = bias + (qpos - key0 - 4 * hh + 63);
#pragma unroll
        for (int i = 0; i < 16; ++i) { st[i] = __builtin_fmaf(st[i], sc[qh], bp[-((i & 3) + 8 * (i >> 2))]); tmax = fmaxf(tmax, st[i]); }
      } else {
#pragma unroll
        for (int i = 0; i < 16; ++i) {
          const int rel = qpos - (key0 + crow(i, hh)); const int idx = (rel > 256 ? 256 : rel) + 63;
          st[i] = __builtin_fmaf(st[i], sc[qh], bias[idx]); tmax = fmaxf(tmax, st[i]);
        }
      }
      tmax = fmaxf(tmax, __shfl_xor(tmax, 32));
      const float mn = fmaxf(m[qh], tmax), alpha = __builtin_amdgcn_exp2f(m[qh] - mn); m[qh] = mn;
      float psum = 0.f;
#pragma unroll
      for (int i = 0; i < 16; ++i) { st[i] = __builtin_amdgcn_exp2f(st[i] - mn); psum += st[i]; }
      lsum[qh] = lsum[qh] * alpha + psum;
      if (__builtin_amdgcn_ballot_w64(alpha != 1.0f) != 0ull) {
#pragma unroll
        for (int i = 0; i < 16; ++i) { o0[qh][i] *= alpha; o1[qh][i] *= alpha; } }
      const bf16x8 p0 = pack8(st, 0), p1 = pack8(st, 1);
      o0[qh] = MFMA32(va[0][0], p0, o0[qh]); o0[qh] = MFMA32(va[0][1], p1, o0[qh]);
      o1[qh] = MFMA32(va[1][0], p0, o1[qh]); o1[qh] = MFMA32(va[1][1], p1, o1[qh]);
    }
#pragma unroll
    for (int s = 0; s < 4; ++s) ka[s] = kan[s];
    va[0][0] = van[0][0]; va[0][1] = van[0][1]; va[1][0] = van[1][0]; va[1][1] = van[1][1];
  }
#pragma unroll
  for (int qh = 0; qh < 2; ++qh) {
    const int qpos = n * 64 + qh * 32 + c;
    float ls = lsum[qh]; ls += __shfl_xor(ls, 32);
    const float linv = __builtin_amdgcn_rcpf(ls);
    bf16_t* yp = Y + (size_t)(b * TSEQ + qpos) * DM + 384 + h * 64 + 4 * hh;
#pragma unroll
    for (int g = 0; g < 4; ++g) {
      u32x2 w; w.x = pkbf(o0[qh][4 * g] * linv, o0[qh][4 * g + 1] * linv); w.y = pkbf(o0[qh][4 * g + 2] * linv, o0[qh][4 * g + 3] * linv); *(u32x2*)(yp + 8 * g) = w;
      u32x2 w1; w1.x = pkbf(o1[qh][4 * g] * linv, o1[qh][4 * g + 1] * linv); w1.y = pkbf(o1[qh][4 * g + 2] * linv, o1[qh][4 * g + 3] * linv); *(u32x2*)(yp + 32 + 8 * g) = w1;
    }
  }
}
DI void phase_chunk(KP p, int l, LAS unsigned char* lds, int tid, int gw, int NGW, int lo, int hi) {
  const int lane = tid & 63;
  const bf16_t* P = (const bf16_t*)(p->ws + WS_U); bf16_t* Y = (bf16_t*)(p->ws + WS_Y);
  LAS float* biasl = (LAS float*)lds;
  for (int i = tid; i < 6 * 320; i += 512) biasl[i] = p->in[24][l * 1920 + i] * LOG2E;
  __syncthreads();
  for (int it = lo + gw; it < hi; it += NGW) {
    const int bhh = it % 48, n = 31 - (it / 48);
    chunk_attn_task(P, (const bf16_t*)(p->ws + WS_VTB), Y, biasl, bhh * 32 + n, lane);
  }
}
DI void phase_attn(KP p, int l, LAS unsigned char* lds, int tid, int gw, int NGW, int bid, int G) {
  const int lane = tid & 63;
  const bf16_t* P = (const bf16_t*)(p->ws + WS_U); bf16_t* Y = (bf16_t*)(p->ws + WS_Y);
  LAS float* biasl = (LAS float*)lds;
  LAS float* pl = (LAS float*)(lds + 8192);
  LAS float* ub = (LAS float*)(lds + 8192 + 16384);
  for (int i = tid; i < 6 * 320; i += 512) biasl[i] = p->in[24][l * 1920 + i] * LOG2E;
  __syncthreads();
  {
    const float* pw = p->in[25] + (size_t)l * 4 * 64 * 64; const float* pscale = p->in[26] + l * 256;
    LAS unsigned short* plb = (LAS unsigned short*)pl;
    const int pwv = tid >> 6, pg = pwv & 3, pl15 = lane & 15, pq4 = lane >> 4;
    bf16x8 pf[2][2]; float psc[2];
#pragma unroll
    for (int dd = 0; dd < 2; ++dd) {
      const int dcol = ((pwv >> 2) * 2 + dd) * 16 + pl15;
      psc[dd] = pscale[pg * 64 + dcol];
#pragma unroll
      for (int s2 = 0; s2 < 2; ++s2) {
        const float* wp = pw + (size_t)pg * 4096 + (size_t)(32 * s2 + 8 * pq4) * 64 + dcol;
        u32x4 w; w.x = pkbf(wp[0], wp[64]); w.y = pkbf(wp[128], wp[192]); w.z = pkbf(wp[256], wp[320]); w.w = pkbf(wp[384], wp[448]);
        pf[dd][s2] = __builtin_bit_cast(bf16x8, w);
      }
    }
    u32x4 pr0 = (u32x4){0u, 0u, 0u, 0u}, pr1 = (u32x4){0u, 0u, 0u, 0u};
    auto pool_fetch = [&](int tile, u32x4& r0, u32x4& r1) {
      const int tok0 = tile * 16, t0 = tok0 & (TSEQ - 1);
      { const int e = tid, rr = e >> 5, c8 = (e & 31) * 8, dt = rr - 15; r0 = (u32x4){0u, 0u, 0u, 0u}; if (t0 + dt >= 0) r0 = *(const u32x4*)(P + (size_t)(tok0 + dt) * PW + PC + c8); }
      { const int e = tid + 512, rr = e >> 5, c8 = (e & 31) * 8, dt = rr - 15; r1 = (u32x4){0u, 0u, 0u, 0u}; if (e < 31 * 32 && t0 + dt >= 0) r1 = *(const u32x4*)(P + (size_t)(tok0 + dt) * PW + PC + c8); }
    };
    if (bid < 1024) pool_fetch(bid, pr0, pr1);
    for (int r2 = 0; r2 < (REPK == 62 ? 2 : 1); ++r2)
    for (int tile = bid; tile < 1024; tile += G) {
      const int tok0 = tile * 16, t0 = tok0 & (TSEQ - 1);
      { float f[8]; unpack8(pr0, f); const int e = tid, rr = e >> 5, c8 = (e & 31) * 8;
        f32x4 a, b2; a[0] = f[0]; a[1] = f[1]; a[2] = f[2]; a[3] = f[3]; b2[0] = f[4]; b2[1] = f[5]; b2[2] = f[6]; b2[3] = f[7];
        *(LAS f32x4*)(ub + rr * 256 + c8) = a; *(LAS f32x4*)(ub + rr * 256 + c8 + 4) = b2; }
      if (tid + 512 < 31 * 32) { float f[8]; unpack8(pr1, f); const int e = tid + 512, rr = e >> 5, c8 = (e & 31) * 8;
        f32x4 a, b2; a[0] = f[0]; a[1] = f[1]; a[2] = f[2]; a[3] = f[3]; b2[0] = f[4]; b2[1] = f[5]; b2[2] = f[6]; b2[3] = f[7];
        *(LAS f32x4*)(ub + rr * 256 + c8) = a; *(LAS f32x4*)(ub + rr * 256 + c8 + 4) = b2; }
      __syncthreads();
      { const int nt = (tile + G < 1024) ? tile + G : tile; pool_fetch(nt, pr0, pr1); }
      __builtin_amdgcn_sched_barrier(0);
#pragma unroll
      for (int k = 0; k < 8; ++k) {
        const int e = tid + 512 * k, i = e >> 8, c = e & 255, g = c >> 6, win = 2 << g;
        const int t = t0 + i, cnt = (t + 1 < win) ? t + 1 : win;
        float s = 0.f;
        for (int jj = 0; jj < win; ++jj) s += ub[(i + 15 - jj) * 256 + c];
        plb[i * 264 + c] = (unsigned short)(pkbf(s * __builtin_amdgcn_rcpf((float)cnt) - ub[(i + 15) * 256 + c], 0.f) & 0xffffu);
      }
      __syncthreads();
      {
        const bf16x8 a0 = *(const LAS bf16x8*)(plb + pl15 * 264 + pg * 64 + 8 * pq4), a1 = *(const LAS bf16x8*)(plb + pl15 * 264 + pg * 64 + 32 + 8 * pq4);
#pragma unroll
        for (int dd = 0; dd < 2; ++dd) {
          f32x4 acc = (f32x4){0.f, 0.f, 0.f, 0.f};
          acc = __builtin_amdgcn_mfma_f32_16x16x32_bf16(a0, pf[dd][0], acc, 0, 0, 0);
          acc = __builtin_amdgcn_mfma_f32_16x16x32_bf16(a1, pf[dd][1], acc, 0, 0, 0);
          const int dcol = ((pwv >> 2) * 2 + dd) * 16 + pl15;
#pragma unroll
          for (int i = 0; i < 4; ++i) Y[(size_t)(tok0 + 4 * pq4 + i) * DM + 768 + pg * 64 + dcol] = (bf16_t)(pkbf(acc[i] * psc[dd], 0.f) & 0xffffu);
        }
      }
      __syncthreads();
    }
  }
  {
    const _Float16* YH = (const _Float16*)(p->ws + WS_YH); const _Float16* BON = (const _Float16*)(p->ws + WS_BON);
    const float* mu = p->in[8] + l * APROJ; const float* g_up = p->in[13] + (size_t)l * 64 * AW; const float* gn_g = p->in[17] + l * AW; const float* gn_b = p->in[18] + l * AW;
    LAS unsigned short* sgb = (LAS unsigned short*)(lds + 8192);
    const int wv = tid >> 6, l15 = lane & 15, q4 = lane >> 4, hd = wv < 6 ? wv : 5;
    bf16x8 gf[4][2];
#pragma unroll
    for (int dt = 0; dt < 4; ++dt)
#pragma unroll
      for (int s2 = 0; s2 < 2; ++s2) {
        const float* gp = g_up + (size_t)(32 * s2 + 8 * q4) * AW + hd * 64 + dt * 16 + l15;
        u32x4 w; w.x = pkbf(gp[0], gp[AW]); w.y = pkbf(gp[2 * AW], gp[3 * AW]); w.z = pkbf(gp[4 * AW], gp[5 * AW]); w.w = pkbf(gp[6 * AW], gp[7 * AW]);
        gf[dt][s2] = __builtin_bit_cast(bf16x8, w);
      }
    float gng[4], gnb[4];
#pragma unroll
    for (int dt = 0; dt < 4; ++dt) { gng[dt] = gn_g[hd * 64 + dt * 16 + l15]; gnb[dt] = gn_b[hd * 64 + dt * 16 + l15]; }
    bf16_t gcur[2], gprv[2]; _Float16 yv[16], bv[16], yn[16], bn[16];
    const float mul0 = mu[1216 + (tid & 63)];
    auto fin_fetch = [&](int tile, bf16_t (&gc)[2], bf16_t (&gp)[2], _Float16 (&y)[16], _Float16 (&bb)[16]) {
      const int tok0 = tile * 16;
#pragma unroll
      for (int q = 0; q < 2; ++q) { const int e = tid + 512 * q, i = e >> 6, j = e & 63, tok = tok0 + i, t = tok & (TSEQ - 1);
        gc[q] = P[(size_t)tok * PW + 1216 + j]; gp[q] = t > 0 ? P[(size_t)(tok - 1) * PW + 1216 + j] : (bf16_t)0; }
#pragma unroll
      for (int i = 0; i < 4; ++i)
#pragma unroll
        for (int dt = 0; dt < 4; ++dt) { const size_t o = (size_t)(tok0 + 4 * q4 + i) * AW + hd * 64 + dt * 16 + l15; y[i * 4 + dt] = YH[o]; bb[i * 4 + dt] = BON[o]; }
    };
    fin_fetch(bid, gcur, gprv, yv, bv);
    for (int r3 = 0; r3 < (REPK == 63 ? 2 : 1); ++r3)
    for (int tile = bid; tile < 1024; tile += G) {
      const int tok0 = tile * 16;
#pragma unroll
      for (int q = 0; q < 2; ++q) { const int e = tid + 512 * q; const float gc = bf2f(gcur[q]), gp = bf2f(gprv[q]); sgb[(e >> 6) * 72 + (e & 63)] = (unsigned short)(pkbf(sigmoidf_(gc + mul0 * (gp - gc)), 0.f) & 0xffffu); }
      __syncthreads();
      { const int nt = (tile + G < 1024) ? tile + G : tile; fin_fetch(nt, gcur, gprv, yn, bn); }
      __builtin_amdgcn_sched_barrier(0);
      if (wv < 6) {
        const bf16x8 a0 = *(const LAS bf16x8*)(sgb + l15 * 72 + 8 * q4), a1 = *(const LAS bf16x8*)(sgb + l15 * 72 + 32 + 8 * q4);
        f32x4 gacc[4];
#pragma unroll
        for (int dt = 0; dt < 4; ++dt) {
          gacc[dt] = (f32x4){0.f, 0.f, 0.f, 0.f};
          gacc[dt] = __builtin_amdgcn_mfma_f32_16x16x32_bf16(a0, gf[dt][0], gacc[dt], 0, 0, 0);
          gacc[dt] = __builtin_amdgcn_mfma_f32_16x16x32_bf16(a1, gf[dt][1], gacc[dt], 0, 0, 0);
        }
#pragma unroll
        for (int i = 0; i < 4; ++i) {
          const size_t tok = tok0 + 4 * q4 + i;
          float y[4], sum = 0.f;
#pragma unroll
          for (int dt = 0; dt < 4; ++dt) { y[dt] = (float)yv[i * 4 + dt]; sum += y[dt]; }
          const float mean = allreduce16(sum) * (1.0f / 64.0f);
          float var = 0.f;
#pragma unroll
          for (int dt = 0; dt < 4; ++dt) { y[dt] -= mean; var += y[dt] * y[dt]; }
          const float rs = __builtin_amdgcn_rsqf(allreduce16(var) * (1.0f / 64.0f) + 64e-5f);
#pragma unroll
          for (int dt = 0; dt < 4; ++dt) {
            const float o = (y[dt] * rs * gng[dt] + gnb[dt] + (float)bv[i * 4 + dt]) * gacc[dt][i];
            Y[tok * DM + hd * 64 + dt * 16 + l15] = (bf16_t)(pkbf(o, 0.f) & 0xffffu);
          }
        }
      }
#pragma unroll
      for (int i = 0; i < 16; ++i) { yv[i] = yn[i]; bv[i] = bn[i]; }
      __syncthreads();
    }
  }
}

constexpr int XK_PITCH = 528, XV_PITCH = 80, XK_BYTES = 32 * XK_PITCH, XV_BYTES = 256 * XV_PITCH, XBUF = XK_BYTES + XV_BYTES;
DI void phase_xattn(KP p, LAS unsigned char* lds, int tid, int bid, int G) {
  const bf16_t* QC = (const bf16_t*)(p->ws + WS_U); bf16_t* OC = (bf16_t*)(p->ws + WS_U + (size_t)MTOK * DM * 2);
  const bf16_t* KNC = (const bf16_t*)(p->ws + WS_KNC); const bf16_t* VTC = (const bf16_t*)(p->ws + WS_VTC);
  const int lane = tid & 63, wave = tid >> 6, c = lane & 31, hh = lane >> 5, qb = wave >> 1, dh = wave & 1;
  const int lk = tid >> 4, lp = tid & 15, ld = tid >> 1, lh = tid & 1;
  for (int u = bid; u < 512; u += G) {
    const int b = u >> 6, h = (u >> 4) & 3, qg = u & 15;
    const size_t qrow = (size_t)(b * TSEQ + qg * 128 + qb * 32 + c);
    const bf16_t* qp = QC + qrow * DM + h * 256 + 8 * hh;
    bf16x8 qreg[16]; float sq = 0.f;
#pragma unroll
    for (int s = 0; s < 16; ++s) { qreg[s] = *(const bf16x8*)(qp + 16 * s); sq += sumsq8(qreg[s]); }
    sq += __shfl_xor(sq, 32);
    const float sc = __builtin_amdgcn_rsqf(sq * (1.0f / 256.0f) + RMS_EPS) * 0.0625f * LOG2E;
    const bf16_t* ksrc = KNC + (size_t)(b * 256 + lk) * 1024 + h * 256 + lp * 16;
    const bf16_t* vsrc = VTC + ((size_t)(b * 4 + h) * 256 + ld) * 256 + lh * 16;
    u32x4 kr0 = *(const u32x4*)ksrc, kr1 = *(const u32x4*)(ksrc + 8), vr0 = *(const u32x4*)vsrc, vr1 = *(const u32x4*)(vsrc + 8);
    __syncthreads();
    { LAS unsigned char* kb = lds + lk * XK_PITCH + lp * 32; *(LAS u32x4*)kb = kr0; *(LAS u32x4*)(kb + 16) = kr1;
      LAS unsigned char* vb = lds + XK_BYTES + ld * XV_PITCH + lh * 32; *(LAS u32x4*)vb = vr0; *(LAS u32x4*)(vb + 16) = vr1; }
    __syncthreads();
    f32x16 o[4];
#pragma unroll
    for (int dt = 0; dt < 4; ++dt)
#pragma unroll
      for (int i = 0; i < 16; ++i) o[dt][i] = 0.f;
    float m = -1e30f, lsum = 0.f;
#pragma unroll 1
    for (int kt = 0; kt < 8; ++kt) {
      if (kt + 1 < 8) { const bf16_t* ks = ksrc + (size_t)(kt + 1) * 32 * 1024; const bf16_t* vs = vsrc + (kt + 1) * 32;
        kr0 = *(const u32x4*)ks; kr1 = *(const u32x4*)(ks + 8); vr0 = *(const u32x4*)vs; vr1 = *(const u32x4*)(vs + 8); }
      const LAS unsigned char* kbase = lds + (kt & 1) * XBUF + c * XK_PITCH + hh * 16;
      const LAS unsigned char* vbase = lds + (kt & 1) * XBUF + XK_BYTES + (dh * 128 + c) * XV_PITCH + hh * 8;
      f32x16 st;
#pragma unroll
      for (int i = 0; i < 16; ++i) st[i] = 0.f;
#pragma unroll
      for (int s = 0; s < 16; ++s) st = MFMA32(*(const LAS bf16x8*)(kbase + s * 32), qreg[s], st);
      float tmax = -1e30f;
#pragma unroll
      for (int i = 0; i < 16; ++i) { st[i] *= sc; tmax = fmaxf(tmax, st[i]); }
      tmax = fmaxf(tmax, __shfl_xor(tmax, 32));
      const float mn = fmaxf(m, tmax), alpha = __builtin_amdgcn_exp2f(m - mn); m = mn;
      float psum = 0.f;
#pragma unroll
      for (int i = 0; i < 16; ++i) { st[i] = __builtin_amdgcn_exp2f(st[i] - mn); psum += st[i]; }
      lsum = lsum * alpha + psum;
      const bf16x8 p0 = pack8(st, 0), p1 = pack8(st, 1);
      const bool resc = __builtin_amdgcn_ballot_w64(alpha != 1.0f) != 0ull;
#pragma unroll
      for (int dt = 0; dt < 4; ++dt) {
        if (resc) {
#pragma unroll
          for (int i = 0; i < 16; ++i) o[dt][i] *= alpha; }
        const LAS unsigned char* vp = vbase + dt * 32 * XV_PITCH;
        const u32x2 a0 = *(const LAS u32x2*)vp, a1 = *(const LAS u32x2*)(vp + 16), a2 = *(const LAS u32x2*)(vp + 32), a3 = *(const LAS u32x2*)(vp + 48);
        u32x4 w0; w0.x = a0.x; w0.y = a0.y; w0.z = a1.x; w0.w = a1.y;
        u32x4 w1; w1.x = a2.x; w1.y = a2.y; w1.z = a3.x; w1.w = a3.y;
        o[dt] = MFMA32(__builtin_bit_cast(bf16x8, w0), p0, o[dt]);
        o[dt] = MFMA32(__builtin_bit_cast(bf16x8, w1), p1, o[dt]);
      }
      if (kt + 1 < 8) {
        LAS unsigned char* nb = lds + ((kt + 1) & 1) * XBUF;
        LAS unsigned char* kb = nb + lk * XK_PITCH + lp * 32; *(LAS u32x4*)kb = kr0; *(LAS u32x4*)(kb + 16) = kr1;
        LAS unsigned char* vb = nb + XK_BYTES + ld * XV_PITCH + lh * 32; *(LAS u32x4*)vb = vr0; *(LAS u32x4*)(vb + 16) = vr1;
      }
      __syncthreads();
    }
    lsum += __shfl_xor(lsum, 32);
    const float linv = __builtin_amdgcn_rcpf(lsum);
    bf16_t* op = OC + qrow * DM + h * 256 + dh * 128 + 4 * hh;
#pragma unroll
    for (int dt = 0; dt < 4; ++dt)
#pragma unroll
      for (int g = 0; g < 4; ++g) {
        u32x2 w; w.x = pkbf(o[dt][4 * g] * linv, o[dt][4 * g + 1] * linv); w.y = pkbf(o[dt][4 * g + 2] * linv, o[dt][4 * g + 3] * linv);
        *(u32x2*)(op + dt * 32 + 8 * g) = w;
      }
  }
}

#define XB_TMO      128
#define XB_XCNT(j)  (256  + 64 * (j))
#define XB_XSUB(j)  (1280 + 64 * (j))
#define XB_XGEN(j)  (2304 + 64 * (j))
#define XB_TOP      3328
#define XB_TOPGEN   3392
#define XB_XSUB(j)  (1280 + 64 * (j))
#define XB_XGEN(j)  (2304 + 64 * (j))
#define XB_TOP      3328
#define XB_TOPGEN   3392
#define XCD_BAR_WORDS 3456
#define XB_SPIN_CAP (1u << 18)

DI unsigned xb_ld(unsigned* p)              { return __hip_atomic_load(p, __ATOMIC_RELAXED, __HIP_MEMORY_SCOPE_AGENT); }
DI unsigned xb_add(unsigned* p, unsigned v) { return __hip_atomic_fetch_add(p, v, __ATOMIC_RELAXED, __HIP_MEMORY_SCOPE_AGENT); }
DI unsigned xb_xcc_id() { return (unsigned)__builtin_amdgcn_s_getreg((3 << 11) | 20) & 0xFu; }
#define XB_SPIN(cond, bar) do { unsigned _sp = 0; while (cond) { __builtin_amdgcn_s_sleep(1); \
    if ((++_sp & 255u) == 0u) { if (xb_ld(&(bar)[XB_TMO])) break; if (_sp > XB_SPIN_CAP) { atomicAdd(&(bar)[XB_TMO], 1u); break; } } } } while (0)

struct XcdBarrier {
    unsigned* bar; unsigned x;
    volatile LAS unsigned* st;
};

DI XcdBarrier xcd_barrier_post(unsigned* bar, volatile LAS unsigned* st) {
    XcdBarrier b; b.bar = bar; b.x = xb_xcc_id(); b.st = st;
    if (threadIdx.x == 0) (void)xb_add(&bar[XB_XCNT(b.x)], 1u);
    return b;
}
DI void xcd_barrier_complete(unsigned* bar, unsigned x, unsigned& nloc, unsigned& nx) {
    const unsigned G = gridDim.x * gridDim.y * gridDim.z;
    unsigned sum, cnt, mine, sp = 0u;
    for (;;) {
        sum = 0u; cnt = 0u; mine = 0u;
#pragma unroll
        for (unsigned j = 0; j < 16; ++j) { const unsigned c = xb_ld(&bar[XB_XCNT(j)]); sum += c; cnt += (c > 0u) ? 1u : 0u; mine = (j == x) ? c : mine; }
        if (sum == G) break;
        __builtin_amdgcn_s_sleep(1);
        if ((++sp & 255u) == 0u) { if (xb_ld(&bar[XB_TMO])) break; if (sp > XB_SPIN_CAP) { atomicAdd(&bar[XB_TMO], 1u); break; } }
    }
    nloc = mine > 0u ? mine : 1u; nx = cnt > 0u ? cnt : 1u;
}

DI void xcd_barrier(const XcdBarrier& b) {
    asm volatile("s_waitcnt vmcnt(0)" ::: "memory");
    __syncthreads();
    if (threadIdx.x == 0) {
        unsigned* bar = b.bar;
        __builtin_amdgcn_s_waitcnt(0);
        unsigned nloc = b.st[0], nx = b.st[1];
        if (nloc == 0u) { xcd_barrier_complete(bar, b.x, nloc, nx); b.st[0] = nloc; b.st[1] = nx; }
        const unsigned old = xb_add(&bar[XB_XSUB(b.x)], 1u);
        const unsigned gen = old / nloc;
        if (old + 1u == (gen + 1u) * nloc) {
            __builtin_amdgcn_fence(__ATOMIC_RELEASE, "agent");
            asm volatile("s_waitcnt vmcnt(0)" ::: "memory");
            const unsigned og = xb_add(&bar[XB_TOP], 1u);
            const unsigned tg = og / nx;
            if (og + 1u == (tg + 1u) * nx) xb_add(&bar[XB_TOPGEN], 1u);
            else XB_SPIN(xb_ld(&bar[XB_TOPGEN]) == tg, bar);
            __builtin_amdgcn_fence(__ATOMIC_ACQUIRE, "agent");
            xb_add(&bar[XB_XGEN(b.x)], 1u);
            asm volatile("s_waitcnt vmcnt(0)" ::: "memory");
        } else {
            XB_SPIN(xb_ld(&bar[XB_XGEN(b.x)]) == gen, bar);
            __builtin_amdgcn_fence(__ATOMIC_ACQUIRE, "agent");
            asm volatile("s_waitcnt vmcnt(0)" ::: "memory");
        }
    }
    __syncthreads();
}

constexpr int LDS_BYTES = 131072 + 64;
constexpr int N_PHASES = 30;
constexpr int SCAN_BLOCKS = 192;
#ifndef HIDE_CONV
#define HIDE_CONV 1
#endif
constexpr int CONV_A = 16 * 176 + 44 * 32 + 16 * 88 + 16 * 64, CONV_ALL = 2 * 16 * 176 + 2 * 44 * 32 + 16 * 88 + 16 * 64 + 3 * 16 * 32;
#ifndef PH_MASK
#define PH_MASK 0xff
#endif
#define EN(k) (((PH_MASK) >> (k)) & 1)
#ifndef REPK
#define REPK -1
#endif
__global__ void __launch_bounds__(512, 2) mk_fwd(Params p) {
  extern __shared__ __attribute__((aligned(16))) unsigned char lds_raw[];
  LAS unsigned char* lds = (LAS unsigned char*)lds_raw;
  cg::grid_group grid = cg::this_grid();
  const int ph_lo = p.ph_lo, ph_hi = p.ph_hi;
  volatile LAS unsigned* bst = (volatile LAS unsigned*)(lds + 131072);
  if (threadIdx.x < 2) bst[threadIdx.x] = 0u;
  __syncthreads();
  XcdBarrier xbar = xcd_barrier_post((unsigned*)(p.ws + WS_BAR), bst);
  int rep = 0; unsigned nbar = 0;
#pragma unroll 1
  for (int ph = ph_lo; ph < ph_hi;) {
    KP kp = (KP)__builtin_amdgcn_kernarg_segment_ptr();
    asm volatile("" : "+s"(kp));
    int tid = threadIdx.x; asm volatile("" : "+v"(tid));
    int bid = blockIdx.x; asm volatile("" : "+s"(bid));
    int G = gridDim.x; asm volatile("" : "+s"(G));
    const int lane = tid & 63, wave = __builtin_amdgcn_readfirstlane(tid >> 6);
    const int gw = bid * 8 + wave, NGW = G * 8;
    unsigned char* ws = kp->ws; unsigned char* W = ws + WS_W;
    bf16_t* XB = (bf16_t*)(ws + WS_XB); float* SS = (float*)(ws + WS_SS); bf16_t* U = (bf16_t*)(ws + WS_U);
    const int l = ph >= 15 ? 1 : 0, s = ph - 15 * l;
    if (s == 6 || s == 7) { ++ph; continue; }
    if (EN(0) && s == 0) {
      phase_conv(kp, l, lds, gw, NGW, wave, lane, 0, CONV_ALL);
      if (l == 0) phase_init(kp, gw, NGW, lane, 0);
    } else if (EN(1) && (s == 1 || s == 13)) {
      pg8::Gemm g{XB, (const bf16_t*)(W + (s == 1 ? W_WI1 : W_WI2)), MTOK, 5632, 1024};
      pg8::StaticOrder S; S.init(MTOK, 5632, G, bid);
      EpiSwiGLU E{U, SS};
      pg8::gemm_phase<EpiSwiGLU, pg8::StaticOrder, true, true>(lds, g, S, E, tid);
    } else if (EN(2) && (s == 2 || s == 14 || s == 9 || s == 12)) {
      const bf16_t* A = (s == 9) ? (const bf16_t*)(ws + WS_Y) : (s == 12) ? (const bf16_t*)(ws + WS_U + (size_t)MTOK * DM * 2) : (const bf16_t*)U;
      const size_t wo = (s == 2) ? W_WO1 : (s == 14) ? W_WO2 : (s == 9) ? W_WOUT : W_WOX;
      pg8::Gemm g{A, (const bf16_t*)(W + wo), MTOK, 1024, (s == 2 || s == 14) ? 2816 : 1024};
      pg8::StaticOrder S; S.init(MTOK, 1024, G, bid);
      EpiResid E{kp->in[0], kp->out, XB, SS, (s == 2 || s == 14) ? 0.5f : 1.0f, ph == 2, ph == N_PHASES - 1};
      pg8::gemm_phase<EpiResid, pg8::StaticOrder, true, true>(lds, g, S, E, tid);
    } else if (EN(3) && (s == 3 || s == 10)) {
      pg8::Gemm g{XB, (const bf16_t*)(W + (s == 3 ? W_WIN : W_WQ)), MTOK, 1024, 1024};
      WinOrder S; S.init(s == 3 ? 2816 : 1024, G, bid, s == 3);
      EpiScaleBf16 E{U, s == 3 ? PW : DM, SS, (bf16_t*)(ws + WS_KVC), 2048, (const float*)(ws + WS_RSM)};
      pg8::gemm_phase<EpiScaleBf16, WinOrder, true, true>(lds, g, S, E, tid);
    } else if (EN(4) && (s == 4 || s == 6)) {
      phase_prep_rwkv(kp, l, 0, lds, tid, bid, G);
      if (s == 4 && rep == 0) { phase_attn_prep<0>(kp, l, lds, gw, NGW, wave, lane); if (G <= SCAN_BLOCKS) phase_attn_prep<1>(kp, l, lds, gw, NGW, wave, lane); }
    } else if (EN(5) && (s == 5 || s == 7)) {
      if (G > SCAN_BLOCKS && bid >= SCAN_BLOCKS) {
        phase_chunk(kp, l, lds, tid, (bid - SCAN_BLOCKS) * 8 + wave, (G - SCAN_BLOCKS) * 8, 0, 1536);
        __syncthreads();
        phase_attn_prep<1>(kp, l, lds, (bid - SCAN_BLOCKS) * 8 + wave, (G - SCAN_BLOCKS) * 8, wave, lane);
      }
      phase_scan(kp, 0, lds, tid, bid);
    } else if (EN(6) && s == 8) {
      if (G <= SCAN_BLOCKS) { phase_chunk(kp, l, lds, tid, gw, NGW, 0, 1536); __syncthreads(); }
      phase_attn(kp, l, lds, tid, gw, NGW, bid, G);
    } else if (EN(7) && s == 11) {
      phase_xattn(kp, lds, tid, bid, G);
    }
    if (REPK >= 0 && REPK < 9) {
      const int kind = (s == 0) ? 0 : (s == 1 || s == 13) ? 1 : (s == 3 || s == 10) ? 3 : (s == 4 || s == 6) ? 4 : (s == 5 || s == 7) ? 5 : (s == 8) ? 6 : (s == 11) ? 7 : 2;
      if (kind == REPK && rep == 0) { rep = 1; if (REPK == 2) xcd_barrier(xbar); __syncthreads(); continue; }
      rep = 0;
    }
    if (ph + 1 < ph_hi) {
      if (ph_hi > 1000) grid.sync();
      xcd_barrier(xbar); if (REPK == 9) xcd_barrier(xbar);
    }
    ++ph;
  }
}

extern "C" void kernel_launch(void* const* d_in, const int* in_sizes, int n_in, void* d_out, int out_size, void* d_ws, size_t ws_size, hipStream_t stream) {
  static int grid = 0;
  if (grid == 0) {
    if (n_in != 37 || out_size != MTOK * DM || ws_size < WS_END) { fprintf(stderr, "kernel_launch: unexpected shapes / workspace (n_in %d out %d ws %zu need %zu)\n", n_in, out_size, ws_size, (size_t)WS_END); grid = -1; return; }
    int dev = 0, cus = 0, per_cu = 0;
    (void)hipGetDevice(&dev);
    (void)hipDeviceGetAttribute(&cus, hipDeviceAttributeMultiprocessorCount, dev);
    (void)hipFuncSetAttribute((const void*)mk_fwd, hipFuncAttributeMaxDynamicSharedMemorySize, LDS_BYTES);
    (void)hipOccupancyMaxActiveBlocksPerMultiprocessor(&per_cu, (const void*)mk_fwd, 512, LDS_BYTES);
    if (per_cu < 1) { fprintf(stderr, "kernel_launch: occupancy query says %d blocks/CU\n", per_cu); per_cu = 1; }
    if (cus < SCAN_BLOCKS) { fprintf(stderr, "kernel_launch: this kernel needs >= %d CUs (found %d)\n", SCAN_BLOCKS, cus); grid = -1; return; }
    grid = cus;
    (void)hipGetLastError();
  }
  if (grid < 0) return;
  Params p{};
  for (int i = 0; i < 37; ++i) p.in[i] = (const float*)d_in[i];
  p.out = (float*)d_out; p.ws = (unsigned char*)d_ws;
  (void)hipMemsetAsync((unsigned char*)d_ws + WS_BAR, 0, 16384, stream);
#if MK_LAUNCHES == 1
  p.ph_lo = 0; p.ph_hi = N_PHASES;
  void* args[] = {&p};
  hipError_t e = hipLaunchCooperativeKernel((const void*)mk_fwd, dim3(grid), dim3(512), args, LDS_BYTES, stream);
  if (e != hipSuccess) fprintf(stderr, "cooperative launch failed: %s (grid %d)\n", hipGetErrorString(e), grid);
#else
  for (int ph = 0; ph < N_PHASES; ++ph) { p.ph_lo = ph; p.ph_hi = ph + 1; hipLaunchKernelGGL(mk_fwd, dim3(grid), dim3(512), LDS_BYTES, stream, p); }
#endif
}
```

```cpp
#include <hip/hip_runtime.h>
#include <hip/hip_cooperative_groups.h>
#include <cstdio>
#include <cstdint>
namespace cg = cooperative_groups;

#ifndef REPK
#define REPK -1
#endif
#ifndef MK_LAUNCHES
#define MK_LAUNCHES 1
#endif

namespace pg8 {
#define PG8_LAS __attribute__((address_space(3)))
typedef unsigned short bf16_t;
typedef short bf16x8 __attribute__((ext_vector_type(8)));
typedef float f32x4 __attribute__((ext_vector_type(4)));
typedef unsigned u32x4 __attribute__((ext_vector_type(4)));
constexpr int BM = 256, BK = 64, HALF = 128, HTB = HALF * BK * 2  , STAGE_BYTES = 8 * HTB, NXCD = 8, WGM = 8;

__host__ __device__ __forceinline__ int lds_byte(int r, int c) { const int st = (r >> 4) * 2 + (c >> 5), rr = r & 15, cc = c & 31, ob = rr * 64 + cc * 2; return st * 1024 + (ob ^ (((ob >> 9) & 1) << 5)); }
__host__ __device__ __forceinline__ void stage_rc(int b, int& R, int& C) { const int st = b / 1024, sb = b % 1024, swz = sb ^ (((sb >> 9) & 1) << 5); R = (st >> 1) * 16 + swz / 64; C = (st & 1) * 32 + (swz % 64) / 2; }
__host__ __device__ __forceinline__ int perm32(int rho) { const int n = rho >> 4, i = rho & 15; return 8 * (i >> 2) + 4 * n + (i & 3); }

struct Unit { int pm, pn; };
struct Gemm { const bf16_t* A; const bf16_t* Bt; int M, N, K; };

struct StaticOrder {
    int nM, nN, nwg, G, c;
    __host__ __device__ void init(int M, int N, int G_, int c_) { nM = M / BM; nN = N / BM; nwg = nM * nN; G = G_; c = c_; }
    __host__ __device__ bool next(int i, Unit& u) const {
        const long L = (long)i * G + c; if (L >= nwg) return false;
        int wgid = (int)L; { const int q = nwg / NXCD, r = nwg % NXCD, xcd = wgid % NXCD, off = wgid / NXCD; wgid = (xcd < r ? xcd * (q + 1) : r * (q + 1) + (xcd - r) * q) + off; }
        const int nig = WGM * nN, gid = wgid / nig, fm = gid * WGM, gsz = (nM - fm) < WGM ? (nM - fm) : WGM;
        u.pm = fm + ((wgid % nig) % gsz); u.pn = (wgid % nig) / gsz; return true;
    }
    __device__ __forceinline__ void a_ready(const Unit&) const {}
    __device__ __forceinline__ void done(const Unit&) const {}
};

template <class Epi, class Sched, bool ALIGN_EPI = false, bool SP2 = false>
__device__ __forceinline__ void gemm_phase(PG8_LAS unsigned char* lds, const Gemm g, const Sched& S, const Epi& E, const int tid) {
    const int wid = __builtin_amdgcn_readfirstlane(tid >> 6), lane = tid & 63, wr = wid >> 2, wc = wid & 3, fr = lane & 15, fq = lane >> 4;
    const int K = g.K, nt = K / BK;
    unsigned voffA[2], voffB[2];
#pragma unroll
    for (int i = 0; i < 2; ++i) { int R, C; stage_rc(tid * 16 + i * 8192, R, C); const int Rb = Epi::PERM ? ((R & ~31) + perm32(R & 31)) : R;
        voffA[i] = (unsigned)(R * K + C) * 2u; voffB[i] = (unsigned)(Rb * K + C) * 2u; }
    const size_t kstep = (size_t)(BK * 2);
    const size_t hstep = (size_t)HALF * K * 2;
    const size_t tstep = 2 * hstep;
    const unsigned ldsw = (unsigned)wid * 1024u;
    const int aoff = lds_byte(wr * 64 + fr, fq * 8), boff = lds_byte(wc * 32 + fr, fq * 8);
#define PG8_SA(b, h) (((b) * 2 + (h)) * HTB)
#define PG8_SB(b, h) ((4 + (b) * 2 + (h)) * HTB)
#define PG8_STAGE(bufoff, gbase, voff) do { _Pragma("unroll") for (int _i = 0; _i < 2; ++_i) \
        __builtin_amdgcn_global_load_lds((const unsigned*)((const char*)(gbase) + (voff)[_i]), (PG8_LAS unsigned*)(lds + (bufoff) + ldsw + _i * 8192), 16, 0, 0); } while (0)
#define PG8_LDA(dst, b, h) do { _Pragma("unroll") for (int m = 0; m < 4; ++m) _Pragma("unroll") for (int k = 0; k < 2; ++k) dst[m][k] = *(const PG8_LAS bf16x8*)(lds + PG8_SA(b, h) + aoff + m * 2048 + k * 1024); } while (0)
#define PG8_LDB(dst, b, h) do { _Pragma("unroll") for (int n = 0; n < 2; ++n) _Pragma("unroll") for (int k = 0; k < 2; ++k) dst[n][k] = *(const PG8_LAS bf16x8*)(lds + PG8_SB(b, h) + boff + n * 2048 + k * 1024); } while (0)
#define PG8_MMA(ai, bj, At, Bt) do { __builtin_amdgcn_s_setprio(1); _Pragma("unroll") for (int m = 0; m < 4; ++m) _Pragma("unroll") for (int n = 0; n < 2; ++n) _Pragma("unroll") for (int k = 0; k < 2; ++k) \
        acc[ai][bj][m][n] = __builtin_amdgcn_mfma_f32_16x16x32_bf16(Bt[n][k], At[m][k], acc[ai][bj][m][n], 0, 0, 0); __builtin_amdgcn_s_setprio(0); } while (0)
#define PG8_WAIT_V(n) asm volatile("s_waitcnt vmcnt(" #n ")" ::: "memory")
#define PG8_WAIT_L(n) asm volatile("s_waitcnt lgkmcnt(" #n ")" ::: "memory")
#define PG8_BAR __builtin_amdgcn_s_barrier()
#define PG8_SCHED __builtin_amdgcn_sched_barrier(0)
    Unit cur, nxt; int ui = 0;
    if (!S.next(0, cur)) return;
    f32x4 acc[2][2][4][2];
#pragma unroll
    for (int a = 0; a < 2; ++a)
#pragma unroll
        for (int b = 0; b < 2; ++b)
#pragma unroll
            for (int m = 0; m < 4; ++m)
#pragma unroll
                for (int n = 0; n < 2; ++n) acc[a][b][m][n] = (f32x4){0.f, 0.f, 0.f, 0.f};
    bf16x8 At[4][2], B0[2][2], B1[2][2];
    const char* cA = (const char*)g.A + (size_t)cur.pm * tstep; const char* cB = (const char*)g.Bt + (size_t)cur.pn * tstep;
    S.a_ready(cur);
    if constexpr (SP2) {
        PG8_STAGE(PG8_SB(0, 0), cB, voffB); PG8_STAGE(PG8_SB(0, 1), cB + hstep, voffB); PG8_STAGE(PG8_SA(0, 0), cA, voffA); PG8_STAGE(PG8_SA(0, 1), cA + hstep, voffA);
        if (wr == 1) PG8_BAR;
        PG8_WAIT_V(2); PG8_BAR;
        PG8_STAGE(PG8_SB(1, 0), cB + kstep, voffB); PG8_STAGE(PG8_SA(1, 0), cA + kstep, voffA); PG8_STAGE(PG8_SB(1, 1), cB + hstep + kstep, voffB);
        PG8_WAIT_V(6); PG8_BAR;
    } else {
        PG8_STAGE(PG8_SB(0, 0), cB, voffB); PG8_STAGE(PG8_SA(0, 0), cA, voffA); PG8_STAGE(PG8_SB(0, 1), cB + hstep, voffB); PG8_STAGE(PG8_SA(0, 1), cA + hstep, voffA);
        if (wr == 1) PG8_BAR;
        PG8_WAIT_V(4); PG8_BAR;
        PG8_STAGE(PG8_SB(1, 0), cB + kstep, voffB); PG8_STAGE(PG8_SA(1, 0), cA + kstep, voffA); PG8_STAGE(PG8_SB(1, 1), cB + hstep + kstep, voffB);
        PG8_WAIT_V(6); PG8_BAR;
    }
    for (;;) {
        const bool has_next = S.next(ui + 1, nxt);
        const char* nA = has_next ? (const char*)g.A + (size_t)nxt.pm * tstep : cA; const char* nB = has_next ? (const char*)g.Bt + (size_t)nxt.pn * tstep : cB;
        for (int t = 0; t < nt; t += 2) {
            const bool last = (t == nt - 2);
            const char* a1 = cA + (size_t)(t + 1) * kstep;
            const char* a2 = last ? nA : cA + (size_t)(t + 2) * kstep; const char* b2 = last ? nB : cB + (size_t)(t + 2) * kstep;
            const char* a3 = a2 + kstep; const char* b3 = b2 + kstep;
            if (last && has_next) S.a_ready(nxt);
            if constexpr (SP2) {
            PG8_LDB(B0, 0, 0); PG8_LDB(B1, 0, 1); PG8_SCHED; PG8_LDA(At, 0, 0); PG8_STAGE(PG8_SA(1, 1), a1 + hstep, voffA);
            PG8_WAIT_V(8); PG8_WAIT_L(0); PG8_BAR; PG8_MMA(0, 0, At, B0); PG8_MMA(0, 1, At, B1); PG8_BAR; PG8_SCHED;
            PG8_LDA(At, 0, 1); PG8_STAGE(PG8_SB(0, 0), b2, voffB); PG8_STAGE(PG8_SB(0, 1), b2 + hstep, voffB); PG8_STAGE(PG8_SA(0, 0), a2, voffA);
            PG8_WAIT_V(8); PG8_WAIT_L(0); PG8_BAR; PG8_MMA(1, 0, At, B0); PG8_MMA(1, 1, At, B1); PG8_BAR; PG8_SCHED;
            PG8_LDB(B0, 1, 0); PG8_LDB(B1, 1, 1); PG8_SCHED; PG8_LDA(At, 1, 0); PG8_STAGE(PG8_SA(0, 1), a2 + hstep, voffA);
            PG8_WAIT_V(8); PG8_WAIT_L(0); PG8_BAR; PG8_MMA(0, 0, At, B0); PG8_MMA(0, 1, At, B1); PG8_BAR; PG8_SCHED;
            PG8_LDA(At, 1, 1); PG8_STAGE(PG8_SB(1, 0), b3, voffB); PG8_STAGE(PG8_SB(1, 1), b3 + hstep, voffB); PG8_STAGE(PG8_SA(1, 0), a3, voffA);
            PG8_WAIT_V(8); PG8_WAIT_L(0); PG8_BAR; PG8_MMA(1, 0, At, B0); PG8_MMA(1, 1, At, B1); PG8_BAR; PG8_SCHED;
            } else {
            PG8_LDB(B0, 0, 0); PG8_SCHED; PG8_LDA(At, 0, 0); PG8_STAGE(PG8_SA(1, 1), a1 + hstep, voffA);
            PG8_WAIT_L(8); PG8_BAR; PG8_WAIT_L(0); PG8_MMA(0, 0, At, B0); PG8_BAR; PG8_SCHED;
            PG8_LDB(B1, 0, 1); PG8_STAGE(PG8_SB(0, 0), b2, voffB);
            PG8_BAR; PG8_WAIT_L(0); PG8_MMA(0, 1, At, B1); PG8_BAR;
            PG8_LDA(At, 0, 1); PG8_STAGE(PG8_SA(0, 0), a2, voffA);
            PG8_BAR; PG8_WAIT_L(0); PG8_MMA(1, 0, At, B0); PG8_BAR; PG8_SCHED;
            PG8_STAGE(PG8_SB(0, 1), b2 + hstep, voffB);
            PG8_WAIT_V(6); PG8_BAR; PG8_MMA(1, 1, At, B1); PG8_BAR;
            PG8_LDB(B0, 1, 0); PG8_SCHED; PG8_LDA(At, 1, 0); PG8_STAGE(PG8_SA(0, 1), a2 + hstep, voffA);
            PG8_WAIT_L(8); PG8_BAR; PG8_WAIT_L(0); PG8_MMA(0, 0, At, B0); PG8_BAR; PG8_SCHED;
            PG8_LDB(B1, 1, 1); PG8_STAGE(PG8_SB(1, 0), b3, voffB);
            PG8_BAR; PG8_WAIT_L(0); PG8_MMA(0, 1, At, B1); PG8_BAR;
            PG8_LDA(At, 1, 1); PG8_STAGE(PG8_SA(1, 0), a3, voffA);
            PG8_BAR; PG8_WAIT_L(0); PG8_MMA(1, 0, At, B0); PG8_BAR; PG8_SCHED;
            PG8_STAGE(PG8_SB(1, 1), b3 + hstep, voffB);
            PG8_WAIT_V(6); PG8_BAR; PG8_MMA(1, 1, At, B1); PG8_BAR;
            }
        }
        if constexpr (ALIGN_EPI) { if (wr == 0) PG8_BAR; }
        if constexpr (!Epi::AFTER_DRAIN) { E(acc, cur, wr, wc, fr, fq); S.done(cur); }
        if (!has_next) break;
#pragma unroll
        for (int a = 0; a < 2; ++a)
#pragma unroll
            for (int b = 0; b < 2; ++b)
#pragma unroll
                for (int m = 0; m < 4; ++m)
#pragma unroll
                    for (int n = 0; n < 2; ++n) acc[a][b][m][n] = (f32x4){0.f, 0.f, 0.f, 0.f};
        cur = nxt; cA = nA; cB = nB; ++ui;
        if constexpr (ALIGN_EPI) { if (wr == 1) PG8_BAR; }
    }
    PG8_WAIT_V(0);
    if constexpr (!ALIGN_EPI) { if (wr == 0) PG8_BAR; }
    PG8_BAR;
    if constexpr (Epi::AFTER_DRAIN) { E.fused(acc, cur, wr, wc, fr, fq, lds, wid, lane); S.done(cur); }
#undef PG8_SA
#undef PG8_SB
#undef PG8_STAGE
#undef PG8_LDA
#undef PG8_LDB
#undef PG8_MMA
#undef PG8_WAIT_V
#undef PG8_WAIT_L
#undef PG8_BAR
#undef PG8_SCHED
}
}

#define LAS __attribute__((address_space(3)))
typedef unsigned short bf16_t;
typedef short bf16x8 __attribute__((ext_vector_type(8)));
typedef short s16x4 __attribute__((ext_vector_type(4)));
typedef float f32x4 __attribute__((ext_vector_type(4)));
typedef float f32x2 __attribute__((ext_vector_type(2)));
typedef float f32x16 __attribute__((ext_vector_type(16)));
typedef unsigned u32x4 __attribute__((ext_vector_type(4)));
typedef unsigned u32x2 __attribute__((ext_vector_type(2)));
typedef _Float16 h4_t __attribute__((ext_vector_type(4)));
typedef _Float16 h8_t __attribute__((ext_vector_type(8)));
typedef __bf16 bfv2_t __attribute__((ext_vector_type(2)));
#define DI __device__ __forceinline__

DI unsigned pkbf(float a, float b) { bfv2_t v = __builtin_convertvector((f32x2){a, b}, bfv2_t); return __builtin_bit_cast(unsigned, v); }
DI float bf2f(unsigned short u) { return __uint_as_float(((unsigned)u) << 16); }
DI float bflo(unsigned u) { return __uint_as_float(u << 16); }
DI float bfhi(unsigned u) { return __uint_as_float(u & 0xffff0000u); }
DI float wave_sum(float v) {
#pragma unroll
  for (int o = 1; o < 64; o <<= 1) v += __shfl_xor(v, o);
  return v;
}
DI float vfma(float a, float b, float c) { float d; asm("v_fma_f32 %0, %1, %2, %3" : "=v"(d) : "v"(a), "v"(b), "v"(c)); return d; }
DI float sigmoidf_(float x) { return __builtin_amdgcn_rcpf(1.0f + __expf(-x)); }
#define LDS_WAIT() asm volatile("s_waitcnt lgkmcnt(0)" ::: "memory")
template <int CTRL> DI float dpp_addx(float x) { return x + __builtin_bit_cast(float, __builtin_amdgcn_update_dpp(0, __builtin_bit_cast(int, x), CTRL, 0xf, 0xf, true)); }
DI float allreduce16(float x) { x = dpp_addx<0xB1>(x); x = dpp_addx<0x4E>(x); x = dpp_addx<0x141>(x); x = dpp_addx<0x140>(x); return x; }
DI float rdlane(float x, int l) { return __builtin_bit_cast(float, __builtin_amdgcn_readlane(__builtin_bit_cast(int, x), l)); }
DI float wave_sum_dpp(float x) { x = allreduce16(x); return (rdlane(x, 0) + rdlane(x, 16)) + (rdlane(x, 32) + rdlane(x, 48)); }


constexpr int MTOK = 16384, DM = 1024, TSEQ = 2048, NB = 8, DFF = 2816, PW = 2816  , NMEM = 256;
constexpr int AW = 384, APROJ = 1280;
constexpr int PQ = 1280, PK = 1664, PV = 2048, PC = 2432;
constexpr int THALF = 1024;
constexpr float RMS_EPS = 1e-6f;

constexpr size_t SZ_WI = (size_t)5632 * 1024 * 2, SZ_WO = (size_t)1024 * 2816 * 2, SZ_WIN = (size_t)2816 * 1024 * 2, SZ_WKV = (size_t)2048 * 1024 * 2, SZ_SQ = (size_t)1024 * 1024 * 2;
constexpr size_t W_WI1 = 0, W_WO1 = W_WI1 + SZ_WI, W_WIN = W_WO1 + SZ_WO, W_WKV = W_WIN + SZ_WIN, W_WOUT = W_WKV + SZ_WKV, W_WQ = W_WOUT + SZ_SQ, W_WOX = W_WQ + SZ_SQ,
                 W_WI2 = W_WOX + SZ_SQ, W_WO2 = W_WI2 + SZ_WI, W_END = W_WO2 + SZ_WO;
constexpr size_t WS_W = 0;
constexpr size_t WS_XB = WS_W + W_END;
constexpr size_t WS_MEMB = WS_XB + (size_t)MTOK * DM * 2;
constexpr size_t WS_U = WS_MEMB + (size_t)2048 * DM * 2;
constexpr size_t WS_R2 = WS_U + (size_t)MTOK * PW * 2;
constexpr size_t WS_VF = WS_R2 + (size_t)48 * THALF * 384 * 2;
constexpr size_t WS_KNC = WS_VF + (size_t)MTOK * AW * 2;
constexpr size_t WS_VTC = WS_KNC + (size_t)2048 * 1024 * 2;
constexpr size_t WS_KVC = WS_VTC + (size_t)2048 * 1024 * 2;
constexpr size_t WS_VTB = WS_KVC + (size_t)2048 * 2048 * 2;
constexpr size_t WS_SS = WS_VTB + (size_t)MTOK * AW * 2;
constexpr size_t WS_RKB = WS_SS + (size_t)MTOK * 16 * 4;
constexpr size_t WS_RSM = WS_RKB + (size_t)48 * 2048 * 4;
constexpr size_t WS_ST = WS_RSM + 2048 * 4;
constexpr size_t WS_BAR = WS_ST + (size_t)48 * 4096 * 4;
constexpr size_t WS_S6X = WS_BAR + 16384;
constexpr size_t S6_BH_BYTES = (size_t)TSEQ * 768;
constexpr size_t WS_END = WS_S6X + 8 * S6_BH_BYTES;
constexpr size_t WS_S6 = WS_XB;
constexpr size_t WS_Y = WS_R2;
constexpr size_t WS_YH = WS_W + W_WI1;
constexpr size_t WS_BON = WS_YH + (size_t)MTOK * AW * 2;
static_assert((size_t)48 * THALF * 384 * 2 == (size_t)(MTOK + 2048) * DM * 2, "S6 half must fit [xb | memb] exactly");
static_assert(2 * (size_t)MTOK * AW * 2 <= W_WOUT, "y + bonus must fit the dead weight prefix");

struct Params { const float* in[37]; float* out; unsigned char* ws; int ph_lo, ph_hi; };
typedef const Params __attribute__((address_space(4)))* KP;
DI unsigned char* s6_block(KP p, int bh) { return bh < 40 ? (unsigned char*)p->out + (size_t)bh * S6_BH_BYTES : p->ws + WS_S6X + (size_t)(bh - 40) * S6_BH_BYTES; }

DI float row_rstd16(const float* ss, int row) {
  const f32x4* p = (const f32x4*)(ss + (size_t)row * 16);
  f32x4 a = p[0], b = p[1], c = p[2], d = p[3];
  float s = ((a[0] + a[1]) + (a[2] + a[3])) + ((b[0] + b[1]) + (b[2] + b[3])) + ((c[0] + c[1]) + (c[2] + c[3])) + ((d[0] + d[1]) + (d[2] + d[3]));
  return __builtin_amdgcn_rsqf(s * (1.0f / 1024.0f) + RMS_EPS);
}
struct EpiScaleBf16 {
  static constexpr bool PERM = true, AFTER_DRAIN = false;
  bf16_t* O1; int ldc1; const float* ss; bf16_t* O2; int ldc2; const float* rs2;
  DI void operator()(const f32x4 (&acc)[2][2][4][2], const pg8::Unit& u, int wr, int wc, int fr, int fq) const {
    const bool kv = u.pm >= 64;
    bf16_t* base = kv ? O2 : O1; const int ldc = kv ? ldc2 : ldc1;
    const int row0 = (kv ? (u.pm - 64) : u.pm) * 256 + wr * 64 + fr, col0 = (kv ? (u.pn - 11) : u.pn) * 256 + wc * 32 + 8 * fq;
#pragma unroll
    for (int ai = 0; ai < 2; ++ai)
#pragma unroll
      for (int m = 0; m < 4; ++m) {
        const int row = row0 + ai * 128 + m * 16;
        const float rs = kv ? rs2[row] : row_rstd16(ss, row);
        bf16_t* rowp = base + (size_t)row * ldc + col0;
#pragma unroll
        for (int bj = 0; bj < 2; ++bj) {
          const f32x4 v0 = acc[ai][bj][m][0] * rs, v1 = acc[ai][bj][m][1] * rs;
          u32x4 w; w.x = pkbf(v0[0], v0[1]); w.y = pkbf(v0[2], v0[3]); w.z = pkbf(v1[0], v1[1]); w.w = pkbf(v1[2], v1[3]);
          *(u32x4*)(rowp + bj * 128) = w;
        }
      }
  }
};
struct EpiSwiGLU {
  static constexpr bool PERM = true, AFTER_DRAIN = false;
  bf16_t* O; const float* ss;
  DI void operator()(const f32x4 (&acc)[2][2][4][2], const pg8::Unit& u, int wr, int wc, int fr, int fq) const {
    const int row0 = u.pm * 256 + wr * 64 + fr, col0 = u.pn * 128 + wc * 32 + 8 * fq;
#pragma unroll
    for (int ai = 0; ai < 2; ++ai)
#pragma unroll
      for (int m = 0; m < 4; ++m) {
        const int row = row0 + ai * 128 + m * 16;
        const float rs = row_rstd16(ss, row);
        float o[8];
#pragma unroll
        for (int n = 0; n < 2; ++n)
#pragma unroll
          for (int j = 0; j < 4; ++j) { const float g = acc[ai][0][m][n][j] * rs, up = acc[ai][1][m][n][j] * rs; o[n * 4 + j] = g * up * __builtin_amdgcn_rcpf(1.0f + __expf(-g)); }
        u32x4 w; w.x = pkbf(o[0], o[1]); w.y = pkbf(o[2], o[3]); w.z = pkbf(o[4], o[5]); w.w = pkbf(o[6], o[7]);
        *(u32x4*)(O + (size_t)row * DFF + col0) = w;
      }
  }
};
struct EpiResid {
  static constexpr bool PERM = true, AFTER_DRAIN = false;
  const float* Xin32; float* Xout32; bf16_t* XB; float* ss; float scale; int first, last;
  DI void operator()(const f32x4 (&acc)[2][2][4][2], const pg8::Unit& u, int wr, int wc, int fr, int fq) const {
    const int row0 = u.pm * 256 + wr * 64 + fr, col0 = u.pn * 256 + wc * 32 + 8 * fq;
#pragma unroll
    for (int ai = 0; ai < 2; ++ai)
#pragma unroll
      for (int m = 0; m < 4; ++m) {
        const int row = row0 + ai * 128 + m * 16; const size_t off = (size_t)row * DM + col0;
        float sq = 0.f;
#pragma unroll
        for (int bj = 0; bj < 2; ++bj) {
          const size_t o = off + bj * 128;
          f32x4 x0, x1;
          if (first) { x0 = *(const f32x4*)(Xin32 + o); x1 = *(const f32x4*)(Xin32 + o + 4); }
          else { const u32x4 ub = *(const u32x4*)(XB + o); x0[0] = bflo(ub.x); x0[1] = bfhi(ub.x); x0[2] = bflo(ub.y); x0[3] = bfhi(ub.y); x1[0] = bflo(ub.z); x1[1] = bfhi(ub.z); x1[2] = bflo(ub.w); x1[3] = bfhi(ub.w); }
          const f32x4 n0 = x0 + acc[ai][bj][m][0] * scale, n1 = x1 + acc[ai][bj][m][1] * scale;
          if (last) { *(f32x4*)(Xout32 + o) = n0; *(f32x4*)(Xout32 + o + 4) = n1; }
          else { u32x4 w; w.x = pkbf(n0[0], n0[1]); w.y = pkbf(n0[2], n0[3]); w.z = pkbf(n1[0], n1[1]); w.w = pkbf(n1[2], n1[3]); *(u32x4*)(XB + o) = w; }
          sq += ((n0[0] * n0[0] + n0[1] * n0[1]) + (n0[2] * n0[2] + n0[3] * n0[3])) + ((n1[0] * n1[0] + n1[1] * n1[1]) + (n1[2] * n1[2] + n1[3] * n1[3]));
        }
        sq += __shfl_xor(sq, 16); sq += __shfl_xor(sq, 32);
        if (fq == 0 && !last) ss[(size_t)row * 16 + u.pn * 4 + wc] = sq;
      }
  }
};
struct WinOrder {
  pg8::StaticOrder so; int G, c, nkv;
  DI void init(int N_, int G_, int c_, int with_kv) { so.init(MTOK, N_, G_, c_); G = G_; c = c_; nkv = with_kv ? 64 : 0; }
  DI bool next(int i, pg8::Unit& u) const {
    const long L = (long)i * G + c;
    if (L < so.nwg) return so.next(i, u);
    const int j = (int)(L - so.nwg); if (j >= nkv) return false;
    u.pm = 64 + (j >> 3); u.pn = 11 + (j & 7); return true;
  }
  DI void a_ready(const pg8::Unit&) const {}
  DI void done(const pg8::Unit&) const {}
};

struct ConvDesc { const float* W; const float* g; bf16_t* WT; int K, Nsrc, mode, nvalid, item, nblk; };
DI void conv_load(const ConvDesc& d, int lane, f32x4 (&v)[8], float (&gv)[8]) {
  const int kb = d.item / d.nblk, nb = d.item % d.nblk, k0 = 64 * kb, n0 = 32 * nb;
  int sc = n0;
  if (d.mode == 1) { const int pn = n0 >> 8, c = n0 & 255; sc = (c < 128) ? (128 * pn + c) : (2816 + 128 * pn + (c - 128)); }
  const bool valid = n0 < d.nvalid;
  const int kr = lane >> 3, n4 = (lane & 7) * 4;
#pragma unroll
  for (int i = 0; i < 8; ++i) {
    const int kk = 8 * i + kr;
    v[i] = valid ? *(const f32x4*)(d.W + (size_t)(k0 + kk) * d.Nsrc + sc + n4) : (f32x4){0.f, 0.f, 0.f, 0.f};
    gv[i] = d.g ? d.g[k0 + kk] : 1.0f;
  }
}
DI void conv_finish(const ConvDesc& d, const f32x4 (&v)[8], const float (&gv)[8], LAS float* scr, int lane) {
  const int kb = d.item / d.nblk, nb = d.item % d.nblk, k0 = 64 * kb, n0 = 32 * nb;
  const int kr = lane >> 3, n4 = (lane & 7) * 4;
#pragma unroll
  for (int i = 0; i < 8; ++i) {
    const int kk = 8 * i + kr; LAS float* dd = scr + kk * 33 + n4;
    dd[0] = v[i][0] * gv[i]; dd[1] = v[i][1] * gv[i]; dd[2] = v[i][2] * gv[i]; dd[3] = v[i][3] * gv[i];
  }
  LDS_WAIT();
  const int c = lane & 7;
#pragma unroll
  for (int j = 0; j < 4; ++j) {
    const int n = (lane >> 3) + 8 * j; const LAS float* s = scr + (8 * c) * 33 + n;
    u32x4 o; o.x = pkbf(s[0 * 33], s[1 * 33]); o.y = pkbf(s[2 * 33], s[3 * 33]); o.z = pkbf(s[4 * 33], s[5 * 33]); o.w = pkbf(s[6 * 33], s[7 * 33]);
    *(u32x4*)(d.WT + (size_t)(n0 + n) * d.K + k0 + 8 * c) = o;
  }
  LDS_WAIT();
}
DI ConvDesc conv_desc(KP p, int l, int it) {
  unsigned char* W = p->ws + WS_W;
  constexpr int I_WI = 16 * 176, I_WO = 44 * 32, I_WIN = 16 * 88, I_WKV = 16 * 64, I_SQ = 16 * 32;
  int r = it;
  if (r < I_WI) return ConvDesc{p->in[3] + (size_t)l * 1024 * 5632, p->in[2] + l * 1024, (bf16_t*)(W + W_WI1), 1024, 5632, 1, 5632, r, 176}; r -= I_WI;
  if (r < I_WO) return ConvDesc{p->in[4] + (size_t)l * 2816 * 1024, nullptr, (bf16_t*)(W + W_WO1), 2816, 1024, 0, 1024, r, 32}; r -= I_WO;
  if (r < I_WIN) return ConvDesc{p->in[6] + (size_t)l * 1024 * 2688, p->in[5] + l * 1024, (bf16_t*)(W + W_WIN), 1024, 2688, 0, 2688, r, 88}; r -= I_WIN;
  if (r < I_WKV) return ConvDesc{p->in[30] + (size_t)l * 1024 * 2048, p->in[28] + l * 1024, (bf16_t*)(W + W_WKV), 1024, 2048, 0, 2048, r, 64}; r -= I_WKV;
  if (r < I_SQ) return ConvDesc{p->in[7] + (size_t)l * 1024 * 1024, nullptr, (bf16_t*)(W + W_WOUT), 1024, 1024, 0, 1024, r, 32}; r -= I_SQ;
  if (r < I_SQ) return ConvDesc{p->in[29] + (size_t)l * 1024 * 1024, p->in[27] + l * 1024, (bf16_t*)(W + W_WQ), 1024, 1024, 0, 1024, r, 32}; r -= I_SQ;
  if (r < I_SQ) return ConvDesc{p->in[31] + (size_t)l * 1024 * 1024, nullptr, (bf16_t*)(W + W_WOX), 1024, 1024, 0, 1024, r, 32}; r -= I_SQ;
  if (r < I_WI) return ConvDesc{p->in[35] + (size_t)l * 1024 * 5632, p->in[34] + l * 1024, (bf16_t*)(W + W_WI2), 1024, 5632, 1, 5632, r, 176}; r -= I_WI;
  return ConvDesc{p->in[36] + (size_t)l * 2816 * 1024, nullptr, (bf16_t*)(W + W_WO2), 2816, 1024, 0, 1024, r, 32};
}
DI void phase_conv(KP p, int l, LAS unsigned char* lds, int gw, int NGW, int wave, int lane, int it_lo, int it_hi) {
  LAS float* scr = (LAS float*)(lds + wave * 8448);
  int it = it_lo + gw;
  if (it >= it_hi) return;
  ConvDesc cur = conv_desc(p, l, it);
  f32x4 v[8]; float gv[8];
  conv_load(cur, lane, v, gv);
  for (; it < it_hi; it += NGW) {
    const bool more = it + NGW < it_hi;
    ConvDesc nxt = cur; f32x4 v2[8]; float gv2[8];
    if (more) { nxt = conv_desc(p, l, it + NGW); conv_load(nxt, lane, v2, gv2); }
    __builtin_amdgcn_sched_barrier(0);
    conv_finish(cur, v, gv, scr, lane);
    if (more) { cur = nxt;
#pragma unroll
      for (int i = 0; i < 8; ++i) { v[i] = v2[i]; gv[i] = gv2[i]; } }
  }
}
DI void phase_init(KP p, int gw, int NGW, int lane, int row_lo) {
  bf16_t* XB = (bf16_t*)(p->ws + WS_XB); float* SS = (float*)(p->ws + WS_SS); float* RSM = (float*)(p->ws + WS_RSM);
  auto row_src = [&](int m) { return m < MTOK ? p->in[0] + (size_t)m * DM : p->in[1] + (size_t)(m - MTOK) * DM; };
  f32x4 nx[4];
  { const int m0 = row_lo + gw; if (m0 < MTOK + 2048) {
#pragma unroll
      for (int j = 0; j < 4; ++j) nx[j] = ((const f32x4*)row_src(m0))[lane + 64 * j]; } }
  for (int m = row_lo + gw; m < MTOK + 2048; m += NGW) {
    const bool isx = m < MTOK;
    f32x4 v[4]; float s = 0.f;
#pragma unroll
    for (int j = 0; j < 4; ++j) v[j] = nx[j];
    { const int mn = (m + NGW < MTOK + 2048) ? m + NGW : m;
#pragma unroll
      for (int j = 0; j < 4; ++j) nx[j] = ((const f32x4*)row_src(mn))[lane + 64 * j]; }
    __builtin_amdgcn_sched_barrier(0);
#pragma unroll
    for (int j = 0; j < 4; ++j) s += (v[j][0] * v[j][0] + v[j][1] * v[j][1]) + (v[j][2] * v[j][2] + v[j][3] * v[j][3]);
    s = wave_sum(s);
    u32x2* o8 = (u32x2*)(XB + (size_t)m * DM);
#pragma unroll
    for (int j = 0; j < 4; ++j) { u32x2 w; w.x = pkbf(v[j][0], v[j][1]); w.y = pkbf(v[j][2], v[j][3]); o8[lane + 64 * j] = w; }
    if (isx) {
      if (lane < 16) SS[(size_t)m * 16 + lane] = lane == 0 ? s : 0.f;
    } else if (lane == 0) RSM[m - MTOK] = __builtin_amdgcn_rsqf(s * (1.0f / 1024.0f) + RMS_EPS);
  }
}

DI void unpack8(const u32x4 u, float (&f)[8]) { f[0] = bflo(u.x); f[1] = bfhi(u.x); f[2] = bflo(u.y); f[3] = bfhi(u.y); f[4] = bflo(u.z); f[5] = bfhi(u.z); f[6] = bflo(u.w); f[7] = bfhi(u.w); }
DI void phase_prep_rwkv(KP p, int l, int hf, LAS unsigned char* lds, int tid, int bid, int G) {
  LAS float* ps = (LAS float*)lds;
  LAS float* vd = ps + 16 * 1280;
  LAS unsigned short* twb = (LAS unsigned short*)(vd + 16 * 32);
  LAS unsigned short* adb = twb + 16 * 40;
  LAS unsigned short* vdb = adb + 16 * 40;
  LAS _Float16* vdT = (LAS _Float16*)(vdb + 16 * 40);
  const bf16_t* P = (const bf16_t*)(p->ws + WS_U);
  _Float16* VF = (_Float16*)(p->ws + WS_VF); float* RKB = (float*)(p->ws + WS_RKB);
  const float* mu = p->in[8] + l * APROJ; const float* w0 = p->in[9] + l * AW; const float* w_up = p->in[10] + l * 32 * AW;
  const float* a0 = p->in[11] + l * AW; const float* a_up = p->in[12] + l * 32 * AW;
  const float* k_k = p->in[14] + l * AW; const float* k_a = p->in[15] + l * AW; const float* r_k = p->in[16] + l * AW;
  const float* v0 = p->in[19]; const float* v_down = p->in[20]; const float* v_up = p->in[21];
  const int lane = tid & 63, wv = tid >> 6, l15 = lane & 15, q4 = lane >> 4, hd = wv < 6 ? wv : 5;
  bf16x8 wf[4], af[4], vf[4]; float w0c[4], a0c[4], v0c[4], kkc[4], kac[4], rkc[4];
#pragma unroll
  for (int dt = 0; dt < 4; ++dt) {
    const int c = hd * 64 + dt * 16 + l15;
    const float* wp = w_up + (size_t)(8 * q4) * AW + c; const float* ap = a_up + (size_t)(8 * q4) * AW + c; const float* vp_ = v_up + (size_t)(8 * q4) * AW + c;
    u32x4 w; w.x = pkbf(wp[0], wp[AW]); w.y = pkbf(wp[2 * AW], wp[3 * AW]); w.z = pkbf(wp[4 * AW], wp[5 * AW]); w.w = pkbf(wp[6 * AW], wp[7 * AW]); wf[dt] = __builtin_bit_cast(bf16x8, w);
    u32x4 x; x.x = pkbf(ap[0], ap[AW]); x.y = pkbf(ap[2 * AW], ap[3 * AW]); x.z = pkbf(ap[4 * AW], ap[5 * AW]); x.w = pkbf(ap[6 * AW], ap[7 * AW]); af[dt] = __builtin_bit_cast(bf16x8, x);
    u32x4 y = (u32x4){0u, 0u, 0u, 0u};
    if (l == 1) { y.x = pkbf(vp_[0], vp_[AW]); y.y = pkbf(vp_[2 * AW], vp_[3 * AW]); y.z = pkbf(vp_[4 * AW], vp_[5 * AW]); y.w = pkbf(vp_[6 * AW], vp_[7 * AW]); }
    vf[dt] = __builtin_bit_cast(bf16x8, y);
    w0c[dt] = w0[c]; a0c[dt] = a0[c]; v0c[dt] = (l == 1) ? v0[c] : 0.f; kkc[dt] = k_k[c]; kac[dt] = k_a[c]; rkc[dt] = r_k[c];
  }
  if (l == 1) { for (int e = tid; e < 384 * 32; e += 512) { const int cc = e >> 5, j = e & 31; vdT[j * 392 + cc] = (_Float16)v_down[e]; } }
  for (int tile = bid; tile < 1024; tile += G) {
    const int b = tile >> 7, t0 = (tile & 127) * 16, tok0 = b * TSEQ + t0;
    _Float16* S6 = (_Float16*)s6_block(p, b * 6 + hd);
    for (int e = tid; e < 2560; e += 512) {
      const int i = e / 160, c8 = (e % 160) * 8;
      const size_t r = (size_t)(tok0 + i) * PW + c8;
      const u32x4 cur = *(const u32x4*)(P + r);
      u32x4 prv = (u32x4){0u, 0u, 0u, 0u};
      if (t0 + i > 0) prv = *(const u32x4*)(P + r - PW);
      float pc[8], pp[8]; unpack8(cur, pc); unpack8(prv, pp);
      const f32x4 m0 = *(const f32x4*)(mu + c8), m1 = *(const f32x4*)(mu + c8 + 4);
      f32x4 o0, o1;
#pragma unroll
      for (int j = 0; j < 4; ++j) { o0[j] = pc[j] + m0[j] * (pp[j] - pc[j]); o1[j] = pc[4 + j] + m1[j] * (pp[4 + j] - pc[4 + j]); }
      *(LAS f32x4*)(ps + i * 1280 + c8) = o0; *(LAS f32x4*)(ps + i * 1280 + c8 + 4) = o1;
    }
    _Float16 vfv[16];
#pragma unroll
    for (int i = 0; i < 4; ++i)
#pragma unroll
      for (int dt = 0; dt < 4; ++dt) vfv[i * 4 + dt] = (l == 1) ? VF[(size_t)(tok0 + 4 * q4 + i) * AW + hd * 64 + dt * 16 + l15] : (_Float16)0.f;
    __syncthreads();
    {
      const int i = tid >> 5, j = tid & 31;
      { const float xv = ps[i * 1280 + 1152 + j]; twb[i * 40 + j] = (unsigned short)(pkbf(1.0f - 2.0f * __builtin_amdgcn_rcpf(1.0f + __expf(2.0f * xv)), 0.f) & 0xffffu); }
      adb[i * 40 + j] = (unsigned short)(pkbf(ps[i * 1280 + 1184 + j], 0.f) & 0xffffu);
      if (l == 1) {
        float s0 = 0.f, s1 = 0.f;
#pragma unroll 4
        for (int cc = 0; cc < 384; cc += 8) {
          const f32x4 pa = *(const LAS f32x4*)(ps + i * 1280 + 768 + cc), pb = *(const LAS f32x4*)(ps + i * 1280 + 768 + cc + 4);
          const h8_t hv = *(const LAS h8_t*)(vdT + j * 392 + cc);
          s0 += (pa[0] * (float)hv[0] + pa[1] * (float)hv[1]) + (pa[2] * (float)hv[2] + pa[3] * (float)hv[3]);
          s1 += (pb[0] * (float)hv[4] + pb[1] * (float)hv[5]) + (pb[2] * (float)hv[6] + pb[3] * (float)hv[7]);
        }
        vdb[i * 40 + j] = (unsigned short)(pkbf(s0 + s1, 0.f) & 0xffffu);
      }
    }
    __syncthreads();
    if (wv < 6) {
      const bf16x8 atw = *(const LAS bf16x8*)(twb + l15 * 40 + 8 * q4), aad = *(const LAS bf16x8*)(adb + l15 * 40 + 8 * q4);
      bf16x8 avd = atw; if (l == 1) avd = *(const LAS bf16x8*)(vdb + l15 * 40 + 8 * q4);
      f32x4 accw[4], acca[4], accv[4];
#pragma unroll
      for (int dt = 0; dt < 4; ++dt) {
        const f32x4 z4 = (f32x4){0.f, 0.f, 0.f, 0.f};
        accw[dt] = __builtin_amdgcn_mfma_f32_16x16x32_bf16(atw, wf[dt], z4, 0, 0, 0);
        acca[dt] = __builtin_amdgcn_mfma_f32_16x16x32_bf16(aad, af[dt], z4, 0, 0, 0);
        accv[dt] = z4; if (l == 1) accv[dt] = __builtin_amdgcn_mfma_f32_16x16x32_bf16(avd, vf[dt], z4, 0, 0, 0);
      }
#pragma unroll
      for (int i = 0; i < 4; ++i) {
        const int ti = 4 * q4 + i, tok = tok0 + ti, t = t0 + ti;
        float kkr[4], kp[4], rr[4], vp[4], aa4[4], om4[4]; float nsum = 0.f, rksum = 0.f;
#pragma unroll
        for (int dt = 0; dt < 4; ++dt) {
          const int c = hd * 64 + dt * 16 + l15;
          const float aw = w0c[dt] + accw[dt][i], aa = a0c[dt] + acca[dt][i], av = v0c[dt] + accv[dt][i];
          const float z = -aw; const float sp = fmaxf(z, 0.f) + __logf(1.0f + __expf(-fabsf(z)));
          const float e = __expf(-sp - 0.5f), xm = -e;
          float om = 1.0f / 40320.0f; om = om * xm + 1.0f / 5040.0f; om = om * xm + 1.0f / 720.0f; om = om * xm + 1.0f / 120.0f; om = om * xm + 1.0f / 24.0f; om = om * xm + 1.0f / 6.0f; om = om * xm + 0.5f; om = om * xm + 1.0f; om = om * xm;
          const float a = sigmoidf_(aa);
          const float r = ps[ti * 1280 + c], k = ps[ti * 1280 + 384 + c], v = ps[ti * 1280 + 768 + c];
          float vpp = v;
          if (l == 0) VF[(size_t)tok * AW + c] = (_Float16)v;
          else { const float vfl = (float)vfv[i * 4 + dt]; vpp = v + (vfl - v) * sigmoidf_(av); }
          kkr[dt] = k * kkc[dt]; nsum += kkr[dt] * kkr[dt];
          kp[dt] = k * (1.0f + (a - 1.0f) * kac[dt]); rksum += r * kp[dt] * rkc[dt];
          rr[dt] = r; vp[dt] = vpp; aa4[dt] = a; om4[dt] = om;
        }
        nsum = allreduce16(nsum); rksum = allreduce16(rksum);
        const float inv = __builtin_amdgcn_rcpf(fmaxf(__builtin_amdgcn_sqrtf(nsum), 1e-12f));
        const size_t base = ((size_t)t * 6) * 64 + l15;
#pragma unroll
        for (int dt = 0; dt < 4; ++dt) {
          const float kk = kkr[dt] * inv; const size_t o = base + dt * 16;
          S6[o] = (_Float16)rr[dt]; S6[o + 64] = (_Float16)kp[dt]; S6[o + 128] = (_Float16)vp[dt]; S6[o + 192] = (_Float16)kk; S6[o + 256] = (_Float16)(-(kk * aa4[dt])); S6[o + 320] = (_Float16)om4[dt];
        }
        if (l15 == 0) RKB[(size_t)(b * 6 + hd) * TSEQ + t] = rksum;
      }
    }
    __syncthreads();
  }
}

DI void transpose64(const bf16_t* src, size_t spitch, bf16_t* dst, size_t dpitch, LAS unsigned short* scr, int lane) {
#pragma unroll
  for (int it = 0; it < 8; ++it) {
    const int row = it * 8 + (lane >> 3), c8 = (lane & 7) * 8;
    const u32x4 v = *(const u32x4*)(src + (size_t)row * spitch + c8);
    LAS unsigned* d = (LAS unsigned*)(scr + row * 66 + c8);
    d[0] = v.x; d[1] = v.y; d[2] = v.z; d[3] = v.w;
  }
  LDS_WAIT();
#pragma unroll
  for (int t8 = 0; t8 < 8; ++t8) {
    unsigned w[4];
#pragma unroll
    for (int j = 0; j < 4; ++j) { const unsigned lo = scr[(t8 * 8 + 2 * j) * 66 + lane], hi = scr[(t8 * 8 + 2 * j + 1) * 66 + lane]; w[j] = lo | (hi << 16); }
    u32x4 o; o.x = w[0]; o.y = w[1]; o.z = w[2]; o.w = w[3];
    *(u32x4*)(dst + (size_t)lane * dpitch + t8 * 8) = o;
  }
  LDS_WAIT();
}
template <int PART> DI void phase_attn_prep(KP p, int l, LAS unsigned char* lds, int gw, int NGW, int wave, int lane) {
  bf16_t* P = (bf16_t*)(p->ws + WS_U);
  LAS unsigned short* scr = (LAS unsigned short*)(lds + wave * 8448);
  if constexpr (PART == 0) {
    const float* qg = p->in[22] + l * 64; const float* kg = p->in[23] + l * 64;
    const int cl = lane < 48 ? lane : 47, d0 = (cl & 7) * 8;
    float gg[8];
#pragma unroll
    for (int j = 0; j < 8; ++j) gg[j] = qg[d0 + j] * kg[d0 + j];
    for (int tok0 = gw; tok0 < MTOK; tok0 += 8 * NGW) {
      u32x4 rows[8];
#pragma unroll
      for (int q = 0; q < 8; ++q) { const int tok = tok0 + q * NGW; rows[q] = (tok < MTOK) ? *(const u32x4*)(P + (size_t)tok * PW + PK + cl * 8) : (u32x4){0u, 0u, 0u, 0u}; }
#pragma unroll
      for (int q = 0; q < 8; ++q) {
        const int tok = tok0 + q * NGW;
        float f[8]; unpack8(rows[q], f);
        float s = 0.f;
#pragma unroll
        for (int j = 0; j < 8; ++j) s += f[j] * f[j];
        s += __shfl_xor(s, 1); s += __shfl_xor(s, 2); s += __shfl_xor(s, 4);
        const float rs = __builtin_amdgcn_rsqf(s * (1.0f / 64.0f) + RMS_EPS);
        u32x4 o; o.x = pkbf(f[0] * rs * gg[0], f[1] * rs * gg[1]); o.y = pkbf(f[2] * rs * gg[2], f[3] * rs * gg[3]); o.z = pkbf(f[4] * rs * gg[4], f[5] * rs * gg[5]); o.w = pkbf(f[6] * rs * gg[6], f[7] * rs * gg[7]);
        if (lane < 48 && tok < MTOK) *(u32x4*)(P + (size_t)tok * PW + PK + cl * 8) = o;
      }
    }
  }
  if constexpr (PART == 0) {
    bf16_t* VTB = (bf16_t*)(p->ws + WS_VTB);
    for (int it = gw; it < 8 * 6 * 32; it += NGW) {
      const int tb = it & 31, h = (it >> 5) % 6, b = it / 192;
      transpose64(P + (size_t)(b * TSEQ + tb * 64) * PW + PV + h * 64, PW, VTB + (size_t)((b * 6 + h) * 64) * TSEQ + tb * 64, TSEQ, scr, lane);
    }
  }
  if constexpr (PART == 1) {
    const bf16_t* KVC = (const bf16_t*)(p->ws + WS_KVC); bf16_t* KNC = (bf16_t*)(p->ws + WS_KNC); bf16_t* VTC = (bf16_t*)(p->ws + WS_VTC);
    const float* qg = p->in[32] + l * 256; const float* kg = p->in[33] + l * 256;
    for (int it = gw; it < 2048 * 4; it += NGW) {
      const int row = it >> 2, h = it & 3;
      const u32x2 u = *(const u32x2*)(KVC + (size_t)row * 2048 + h * 256 + lane * 4);
      const float f0 = bflo(u.x), f1 = bfhi(u.x), f2 = bflo(u.y), f3 = bfhi(u.y);
      const float s = wave_sum((f0 * f0 + f1 * f1) + (f2 * f2 + f3 * f3));
      const float rs = __builtin_amdgcn_rsqf(s * (1.0f / 256.0f) + RMS_EPS);
      const f32x4 a = *(const f32x4*)(qg + lane * 4), bb = *(const f32x4*)(kg + lane * 4);
      u32x2 o; o.x = pkbf(f0 * rs * a[0] * bb[0], f1 * rs * a[1] * bb[1]); o.y = pkbf(f2 * rs * a[2] * bb[2], f3 * rs * a[3] * bb[3]);
      *(u32x2*)(KNC + (size_t)row * 1024 + h * 256 + lane * 4) = o;
    }
    for (int it = gw; it < 8 * 4 * 16; it += NGW) {
      const int mt = it & 3, dt = (it >> 2) & 3, h = (it >> 4) & 3, b = it >> 6;
      transpose64(KVC + (size_t)(b * 256 + mt * 64) * 2048 + 1024 + h * 256 + dt * 64, 2048, VTC + (size_t)((b * 4 + h) * 256 + dt * 64) * 256 + mt * 64, 256, scr, lane);
    }
  }
}

constexpr int SCAN_STEP_B = 1152, SCAN_CHUNK_B = 32 * SCAN_STEP_B;
DI void scan_issue(const unsigned char* src, int lt, u32x4 (&v)[6]) {
#pragma unroll
  for (int q = 0; q < 6; ++q) v[q] = *(const u32x4*)(src + (size_t)(q * 256 + lt) * 16);
}
DI void scan_write(const u32x4 (&v)[6], LAS unsigned char* dst, int lt) {
#pragma unroll
  for (int q = 0; q < 6; ++q) {
    const int e = (q * 256 + lt) * 8, t = e / 384, rem = e - t * 384, X = rem >> 6, c = rem & 63;
    LAS unsigned char* d = dst + t * SCAN_STEP_B;
    if (X == 1 || X == 4 || X == 5) {
      const h8_t hv = __builtin_bit_cast(h8_t, v[q]);
      f32x4 a, b; a[0] = (float)hv[0]; a[1] = (float)hv[1]; a[2] = (float)hv[2]; a[3] = (float)hv[3]; b[0] = (float)hv[4]; b[1] = (float)hv[5]; b[2] = (float)hv[6]; b[3] = (float)hv[7];
      LAS unsigned char* dd = d + (X == 1 ? 0 : X == 4 ? 256 : 512) + c * 4;
      *(LAS f32x4*)dd = a; *(LAS f32x4*)(dd + 16) = b;
    } else {
      *(LAS u32x4*)(d + (X == 0 ? 768 : X == 3 ? 896 : 1024) + c * 2) = v[q];
    }
  }
}
DI void phase_scan(KP p, int hf, LAS unsigned char* lds, int tid, int bid) {
  if (bid >= 192) return;
  const int bh = bid >> 2, rg = bid & 3, b = bh / 6, h = bh % 6;
  const int wave = tid >> 6, lane = tid & 63;
  LAS unsigned char* buf = lds;
  const unsigned char* S6 = s6_block(p, bh);
  const float* RKB = (const float*)(p->ws + WS_RKB) + (size_t)bh * TSEQ;
  _Float16* YH = (_Float16*)(p->ws + WS_YH); _Float16* BON = (_Float16*)(p->ws + WS_BON);
  bool is_comp = wave < 4; int widx = wave & 3;
  {
    LAS int* roles = (LAS int*)(lds + 2 * SCAN_CHUNK_B);
    const int simd = (int)__builtin_amdgcn_s_getreg((1 << 11) | (4 << 6) | 4);
    if (lane == 0) roles[wave] = simd;
    __syncthreads();
    int sid[8], rk[8], nfirst = 0;
#pragma unroll
    for (int w = 0; w < 8; ++w) sid[w] = roles[w];
#pragma unroll
    for (int w = 0; w < 8; ++w) { int r = 0;
#pragma unroll
      for (int u = 0; u < 8; ++u) if (u < w && sid[u] == sid[w]) ++r;
      rk[w] = r; nfirst += (r == 0); }
    if (nfirst == 4) {
      int myr = 0, ci = 0, li = 0;
#pragma unroll
      for (int w = 0; w < 8; ++w) { if (w == wave) myr = rk[w]; if (w < wave) { ci += (rk[w] == 0); li += (rk[w] != 0); } }
      is_comp = (myr == 0); widx = is_comp ? ci : li;
    }
    __syncthreads();
  }
  const int kq = lane & 15, v = 16 * rg + 4 * widx + (lane >> 4);
  f32x2 S01 = {0.f, 0.f}, S23 = {0.f, 0.f};
  const int lt = widx * 64 + lane;
  u32x4 R[6]; unsigned bvv = 0u; float brk = 0.f;
  const int bt = lt >> 3, br2 = (lt & 7) * 2;
  if (!is_comp) {
    scan_issue(S6, lt, R); scan_write(R, buf, lt); scan_issue(S6 + 24576, lt, R);
    bvv = *(const unsigned*)(S6 + ((size_t)(bt * 6 + 2) * 64 + 16 * rg + br2) * 2); brk = RKB[bt];
  }

  __syncthreads();
  if (is_comp) __builtin_amdgcn_s_setprio(3);
  const size_t obase = (size_t)(b * TSEQ) * AW + h * 64;
  h4_t rp4 = {(_Float16)0.f, (_Float16)0.f, (_Float16)0.f, (_Float16)0.f}; float ykeep = 0.f;
  float ysel[16];
#pragma unroll
  for (int j = 0; j < 16; ++j) ysel[j] = (kq == j) ? 1.0f : 0.f;
  for (int ch = 0; ch < 64; ++ch) {
    if (!is_comp) {
      if (ch + 1 < 64) scan_write(R, buf + ((ch + 1) & 1) * SCAN_CHUNK_B, lt);
      if (ch + 2 < 64) scan_issue(S6 + (size_t)(ch + 2) * 24576, lt, R);
      {
        const h4_t hv = __builtin_bit_cast(h4_t, (u32x2){bvv, 0u});
        typedef _Float16 h2_t __attribute__((ext_vector_type(2)));
        h2_t o; o[0] = (_Float16)(brk * (float)hv[0]); o[1] = (_Float16)(brk * (float)hv[1]);
        *(h2_t*)(BON + obase + (size_t)(ch * 32 + bt) * AW + 16 * rg + br2) = o;
        if (ch + 1 < 64) { bvv = *(const unsigned*)(S6 + (size_t)(ch + 1) * 24576 + ((size_t)(bt * 6 + 2) * 64 + 16 * rg + br2) * 2); brk = RKB[(ch + 1) * 32 + bt]; }
      }
    } else {
      const LAS unsigned char* cb = buf + (ch & 1) * SCAN_CHUNK_B;
      f32x4 k4 = *(const LAS f32x4*)(cb + kq * 16), nb4 = *(const LAS f32x4*)(cb + 256 + kq * 16), nom4 = *(const LAS f32x4*)(cb + 512 + kq * 16);
      h4_t r4 = *(const LAS h4_t*)(cb + 768 + kq * 8), kk4 = *(const LAS h4_t*)(cb + 896 + kq * 8);
      _Float16 vh = *(const LAS _Float16*)(cb + 1024 + v * 2);
      f32x4 k4n = *(const LAS f32x4*)(cb + SCAN_STEP_B + kq * 16), nb4n = *(const LAS f32x4*)(cb + SCAN_STEP_B + 256 + kq * 16), nom4n = *(const LAS f32x4*)(cb + SCAN_STEP_B + 512 + kq * 16);
      h4_t r4n = *(const LAS h4_t*)(cb + SCAN_STEP_B + 768 + kq * 8), kk4n = *(const LAS h4_t*)(cb + SCAN_STEP_B + 896 + kq * 8);
      _Float16 vhn = *(const LAS _Float16*)(cb + SCAN_STEP_B + 1024 + v * 2);
#pragma unroll 16
      for (int s = 0; s < 32; ++s) {
        const LAS unsigned char* sb = cb + (s + 2 < 32 ? s + 2 : 31) * SCAN_STEP_B;
        const f32x4 k4m = *(const LAS f32x4*)(sb + kq * 16), nb4m = *(const LAS f32x4*)(sb + 256 + kq * 16), nom4m = *(const LAS f32x4*)(sb + 512 + kq * 16);
        const h4_t r4m = *(const LAS h4_t*)(sb + 768 + kq * 8), kk4m = *(const LAS h4_t*)(sb + 896 + kq * 8);
        const _Float16 vhm = *(const LAS _Float16*)(sb + 1024 + v * 2);
        __builtin_amdgcn_sched_barrier(0);
        const float vv = (float)vh;
        float sa = __builtin_fmaf(S01[0], (float)kk4[0], 0.f), y = __builtin_fmaf(S01[0], (float)rp4[0], 0.f);
        sa = __builtin_fmaf(S01[1], (float)kk4[1], sa); y = __builtin_fmaf(S01[1], (float)rp4[1], y);
        sa = __builtin_fmaf(S23[0], (float)kk4[2], sa); y = __builtin_fmaf(S23[0], (float)rp4[2], y);
        sa = __builtin_fmaf(S23[1], (float)kk4[3], sa); y = __builtin_fmaf(S23[1], (float)rp4[3], y);
        float t0 = vfma(vv, k4[0], S01[0]), t1 = vfma(vv, k4[1], S01[1]), t2 = vfma(vv, k4[2], S23[0]), t3 = vfma(vv, k4[3], S23[1]);
        sa = dpp_addx<0xB1>(sa); y = dpp_addx<0xB1>(y); sa = dpp_addx<0x4E>(sa); y = dpp_addx<0x4E>(y);
        sa = dpp_addx<0x141>(sa); y = dpp_addx<0x141>(y); sa = dpp_addx<0x140>(sa); y = dpp_addx<0x140>(y);
        t0 = vfma(sa, nb4[0], t0); t1 = vfma(sa, nb4[1], t1); t2 = vfma(sa, nb4[2], t2); t3 = vfma(sa, nb4[3], t3);
        S01[0] = vfma(nom4[0], S01[0], t0); S01[1] = vfma(nom4[1], S01[1], t1); S23[0] = vfma(nom4[2], S23[0], t2); S23[1] = vfma(nom4[3], S23[1], t3);
        ykeep = __builtin_fmaf(y, ysel[(s + 15) & 15], ykeep);
        if ((s & 15) == 0) { if ((ch | s) != 0) YH[obase + (size_t)(ch * 32 + s - 16 + kq) * AW + v] = (_Float16)ykeep; ykeep = 0.f; }
        rp4 = r4; k4 = k4n; nb4 = nb4n; nom4 = nom4n; r4 = r4n; kk4 = kk4n; vh = vhn;
        k4n = k4m; nb4n = nb4m; nom4n = nom4m; r4n = r4m; kk4n = kk4m; vhn = vhm;
        __builtin_amdgcn_sched_barrier(0);
      }
    }
    asm volatile("s_waitcnt lgkmcnt(0)" ::: "memory"); __builtin_amdgcn_s_barrier(); asm volatile("" ::: "memory");
  }
  __builtin_amdgcn_s_setprio(0);
  if (is_comp) {
    float y = S01[0] * (float)rp4[0]; y = __builtin_fmaf(S01[1], (float)rp4[1], y); y = __builtin_fmaf(S23[0], (float)rp4[2], y); y = __builtin_fmaf(S23[1], (float)rp4[3], y);
    y = allreduce16(y);
    ykeep = __builtin_fmaf(y, ysel[15], ykeep);
    YH[obase + (size_t)(TSEQ - 16 + kq) * AW + v] = (_Float16)ykeep;
  }

}

#define MFMA32(a, b, c) __builtin_amdgcn_mfma_f32_32x32x16_bf16((a), (b), (c), 0, 0, 0)
constexpr float LOG2E = 1.4426950408889634f;
DI int crow(int r, int hi) { return (r & 3) + 8 * (r >> 2) + 4 * hi; }
DI bf16x8 pack8(const f32x16& x, int s) {
  u32x4 pk; pk.x = pkbf(x[8 * s], x[8 * s + 1]); pk.y = pkbf(x[8 * s + 2], x[8 * s + 3]); pk.z = pkbf(x[8 * s + 4], x[8 * s + 5]); pk.w = pkbf(x[8 * s + 6], x[8 * s + 7]);
  return __builtin_bit_cast(bf16x8, pk);
}
DI bf16x8 ld2x4(const bf16_t* p0) {
  const u32x2 a = *(const u32x2*)p0, b = *(const u32x2*)(p0 + 8);
  u32x4 r; r.x = a.x; r.y = a.y; r.z = b.x; r.w = b.y; return __builtin_bit_cast(bf16x8, r);
}
DI float sumsq8(const bf16x8 v) { const u32x4 u = __builtin_bit_cast(u32x4, v); float f[8]; unpack8(u, f); float s = 0.f;
#pragma unroll
  for (int j = 0; j < 8; ++j) s += f[j] * f[j];
  return s; }
DI void chunk_attn_task(const bf16_t* P, const bf16_t* VTB, bf16_t* Y, const LAS float* biasl, int task, int lane) {
  const int n = task & 31, bhh = task >> 5, h = bhh % 6, b = bhh / 6;
  const int c = lane & 31, hh = lane >> 5;
  bf16x8 qb[2][4]; float sc[2], m[2], lsum[2]; f32x16 o0[2], o1[2];
#pragma unroll
  for (int qh = 0; qh < 2; ++qh) {
    const int qpos = n * 64 + qh * 32 + c;
    const bf16_t* qp = P + (size_t)(b * TSEQ + qpos) * PW + PQ + h * 64 + 8 * hh;
    float sq = 0.f;
#pragma unroll
    for (int s = 0; s < 4; ++s) { qb[qh][s] = *(const bf16x8*)(qp + 16 * s); sq += sumsq8(qb[qh][s]); }
    sq += __shfl_xor(sq, 32);
    sc[qh] = __builtin_amdgcn_rsqf(sq * (1.0f / 64.0f) + RMS_EPS) * 0.125f * LOG2E;
    m[qh] = -1e30f; lsum[qh] = 0.f;
#pragma unroll
    for (int i = 0; i < 16; ++i) { o0[qh][i] = 0.f; o1[qh][i] = 0.f; }
  }
  const int kt0 = (n > 8 ? n - 8 : 0) * 2, kt1 = (n + 1) * 2;
  const bf16_t* Kb = P + (size_t)(b * TSEQ + c) * PW + PK + h * 64 + 8 * hh;
  const bf16_t* Vt = VTB + ((size_t)(b * 6 + h) * 64 + c) * TSEQ + 4 * hh;
  const LAS float* bias = biasl + h * 320;
  bf16x8 ka[4], va[2][2];
#pragma unroll
  for (int s = 0; s < 4; ++s) ka[s] = *(const bf16x8*)(Kb + (size_t)(kt0 * 32) * PW + 16 * s);
#pragma unroll
  for (int dt = 0; dt < 2; ++dt)
#pragma unroll
    for (int s2 = 0; s2 < 2; ++s2) va[dt][s2] = ld2x4(Vt + (size_t)dt * 32 * TSEQ + kt0 * 32 + 16 * s2);
#pragma unroll 1
  for (int kt = kt0; kt < kt1; ++kt) {
    const int key0 = kt * 32, keyn = (kt + 1 < kt1 ? kt + 1 : kt) * 32;
    bf16x8 kan[4], van[2][2];
#pragma unroll
    for (int s = 0; s < 4; ++s) kan[s] = *(const bf16x8*)(Kb + (size_t)keyn * PW + 16 * s);
#pragma unroll
    for (int dt = 0; dt < 2; ++dt)
#pragma unroll
      for (int s2 = 0; s2 < 2; ++s2) van[dt][s2] = ld2x4(Vt + (size_t)dt * 32 * TSEQ + keyn + 16 * s2);
    __builtin_amdgcn_sched_barrier(0);
#pragma unroll
    for (int qh = 0; qh < 2; ++qh) {
      const int qpos = n * 64 + qh * 32 + c;
      f32x16 st;
#pragma unroll
      for (int i = 0; i < 16; ++i) st[i] = 0.f;
#pragma unroll
      for (int s = 0; s < 4; ++s) st = MFMA32(ka[s], qb[qh][s], st);
      float tmax = -1e30f;
      const int qlo = n * 64 + qh * 32;
      if (qlo - (key0 + 31) >= 256) {
        const float bc = bias[319];
#pragma unroll
        for (int i = 0; i < 16; ++i) { st[i] = __builtin_fmaf(st[i], sc[qh], bc); tmax = fmaxf(tmax, st[i]); }
      } else if (qlo + 31 - key0 <= 256) {
        const LAS float* bp = bias + (qpos - key0 - 4 * hh + 63);
#pragma unroll
        for (int i = 0; i < 16; ++i) { st[i] = __builtin_fmaf(st[i], sc[qh], bp[-((i & 3) + 8 * (i >> 2))]); tmax = fmaxf(tmax, st[i]); }
      } else {
#pragma unroll
        for (int i = 0; i < 16; ++i) {
          const int rel = qpos - (key0 + crow(i, hh)); const int idx = (rel > 256 ? 256 : rel) + 63;
          st[i] = __builtin_fmaf(st[i], sc[qh], bias[idx]); tmax = fmaxf(tmax, st[i]);
        }
      }
      tmax = fmaxf(tmax, __shfl_xor(tmax, 32));
      const float mn = fmaxf(m[qh], tmax), alpha = __builtin_amdgcn_exp2f(m[qh] - mn); m[qh] = mn;
      float psum = 0.f;
#pragma unroll
      for (int i = 0; i < 16; ++i) { st[i] = __builtin_amdgcn_exp2f(st[i] - mn); psum += st[i]; }
      lsum[qh] = lsum[qh] * alpha + psum;
      if (__builtin_amdgcn_ballot_w64(alpha != 1.0f) != 0ull) {
#pragma unroll
        for (int i = 0; i < 16; ++i) { o0[qh][i] *= alpha; o1[qh][i] *= alpha; } }
      const bf16x8 p0 = pack8(st, 0), p1 = pack8(st, 1);
      o0[qh] = MFMA32(va[0][0], p0, o0[qh]); o0[qh] = MFMA32(va[0][1], p1, o0[qh]);
      o1[qh] = MFMA32(va[1][0], p0, o1[qh]); o1[qh] = MFMA32(va[1][1], p1, o1[qh]);
    }
#pragma unroll
    for (int s = 0; s < 4; ++s) ka[s] = kan[s];
    va[0][0] = van[0][0]; va[0][1] = van[0][1]; va[1][0] = van[1][0]; va[1][1] = van[1][1];
  }
#pragma unroll
  for (int qh = 0; qh < 2; ++qh) {
    const int qpos = n * 64 + qh * 32 + c;
    float ls = lsum[qh]; ls += __shfl_xor(ls, 32);
    const float linv = __builtin_amdgcn_rcpf(ls);
    bf16_t* yp = Y + (size_t)(b * TSEQ + qpos) * DM + 384 + h * 64 + 4 * hh;
#pragma unroll
    for (int g = 0; g < 4; ++g) {
      u32x2 w; w.x = pkbf(o0[qh][4 * g] * linv, o0[qh][4 * g + 1] * linv); w.y = pkbf(o0[qh][4 * g + 2] * linv, o0[qh][4 * g + 3] * linv); *(u32x2*)(yp + 8 * g) = w;
      u32x2 w1; w1.x = pkbf(o1[qh][4 * g] * linv, o1[qh][4 * g + 1] * linv); w1.y = pkbf(o1[qh][4 * g + 2] * linv, o1[qh][4 * g + 3] * linv); *(u32x2*)(yp + 32 + 8 * g) = w1;
    }
  }
}
DI void phase_chunk(KP p, int l, LAS unsigned char* lds, int tid, int gw, int NGW, int lo, int hi) {
  const int lane = tid & 63;
  const bf16_t* P = (const bf16_t*)(p->ws + WS_U); bf16_t* Y = (bf16_t*)(p->ws + WS_Y);
  LAS float* biasl = (LAS float*)lds;
  for (int i = tid; i < 6 * 320; i += 512) biasl[i] = p->in[24][l * 1920 + i] * LOG2E;
  __syncthreads();
  for (int it = lo + gw; it < hi; it += NGW) {
    const int bhh = it % 48, n = 31 - (it / 48);
    chunk_attn_task(P, (const bf16_t*)(p->ws + WS_VTB), Y, biasl, bhh * 32 + n, lane);
  }
}
DI void phase_attn(KP p, int l, LAS unsigned char* lds, int tid, int gw, int NGW, int bid, int G) {
  const int lane = tid & 63;
  const bf16_t* P = (const bf16_t*)(p->ws + WS_U); bf16_t* Y = (bf16_t*)(p->ws + WS_Y);
  LAS float* biasl = (LAS float*)lds;
  LAS float* pl = (LAS float*)(lds + 8192);
  LAS float* ub = (LAS float*)(lds + 8192 + 16384);
  for (int i = tid; i < 6 * 320; i += 512) biasl[i] = p->in[24][l * 1920 + i] * LOG2E;
  __syncthreads();
  {
    const float* pw = p->in[25] + (size_t)l * 4 * 64 * 64; const float* pscale = p->in[26] + l * 256;
    LAS unsigned short* plb = (LAS unsigned short*)pl;
    const int pwv = tid >> 6, pg = pwv & 3, pl15 = lane & 15, pq4 = lane >> 4;
    bf16x8 pf[2][2]; float psc[2];
#pragma unroll
    for (int dd = 0; dd < 2; ++dd) {
      const int dcol = ((pwv >> 2) * 2 + dd) * 16 + pl15;
      psc[dd] = pscale[pg * 64 + dcol];
#pragma unroll
      for (int s2 = 0; s2 < 2; ++s2) {
        const float* wp = pw + (size_t)pg * 4096 + (size_t)(32 * s2 + 8 * pq4) * 64 + dcol;
        u32x4 w; w.x = pkbf(wp[0], wp[64]); w.y = pkbf(wp[128], wp[192]); w.z = pkbf(wp[256], wp[320]); w.w = pkbf(wp[384], wp[448]);
        pf[dd][s2] = __builtin_bit_cast(bf16x8, w);
      }
    }
    u32x4 pr0 = (u32x4){0u, 0u, 0u, 0u}, pr1 = (u32x4){0u, 0u, 0u, 0u};
    auto pool_fetch = [&](int tile, u32x4& r0, u32x4& r1) {
      const int tok0 = tile * 16, t0 = tok0 & (TSEQ - 1);
      { const int e = tid, rr = e >> 5, c8 = (e & 31) * 8, dt = rr - 15; r0 = (u32x4){0u, 0u, 0u, 0u}; if (t0 + dt >= 0) r0 = *(const u32x4*)(P + (size_t)(tok0 + dt) * PW + PC + c8); }
      { const int e = tid + 512, rr = e >> 5, c8 = (e & 31) * 8, dt = rr - 15; r1 = (u32x4){0u, 0u, 0u, 0u}; if (e < 31 * 32 && t0 + dt >= 0) r1 = *(const u32x4*)(P + (size_t)(tok0 + dt) * PW + PC + c8); }
    };
    if (bid < 1024) pool_fetch(bid, pr0, pr1);
    for (int r2 = 0; r2 < (REPK == 62 ? 2 : 1); ++r2)
    for (int tile = bid; tile < 1024; tile += G) {
      const int tok0 = tile * 16, t0 = tok0 & (TSEQ - 1);
      { float f[8]; unpack8(pr0, f); const int e = tid, rr = e >> 5, c8 = (e & 31) * 8;
        f32x4 a, b2; a[0] = f[0]; a[1] = f[1]; a[2] = f[2]; a[3] = f[3]; b2[0] = f[4]; b2[1] = f[5]; b2[2] = f[6]; b2[3] = f[7];
        *(LAS f32x4*)(ub + rr * 256 + c8) = a; *(LAS f32x4*)(ub + rr * 256 + c8 + 4) = b2; }
      if (tid + 512 < 31 * 32) { float f[8]; unpack8(pr1, f); const int e = tid + 512, rr = e >> 5, c8 = (e & 31) * 8;
        f32x4 a, b2; a[0] = f[0]; a[1] = f[1]; a[2] = f[2]; a[3] = f[3]; b2[0] = f[4]; b2[1] = f[5]; b2[2] = f[6]; b2[3] = f[7];
        *(LAS f32x4*)(ub + rr * 256 + c8) = a; *(LAS f32x4*)(ub + rr * 256 + c8 + 4) = b2; }
      __syncthreads();
      { const int nt = (tile + G < 1024) ? tile + G : tile; pool_fetch(nt, pr0, pr1); }
      __builtin_amdgcn_sched_barrier(0);
#pragma unroll
      for (int k = 0; k < 8; ++k) {
        const int e = tid + 512 * k, i = e >> 8, c = e & 255, g = c >> 6, win = 2 << g;
        const int t = t0 + i, cnt = (t + 1 < win) ? t + 1 : win;
        float s = 0.f;
        for (int jj = 0; jj < win; ++jj) s += ub[(i + 15 - jj) * 256 + c];
        plb[i * 264 + c] = (unsigned short)(pkbf(s * __builtin_amdgcn_rcpf((float)cnt) - ub[(i + 15) * 256 + c], 0.f) & 0xffffu);
      }
      __syncthreads();
      {
        const bf16x8 a0 = *(const LAS bf16x8*)(plb + pl15 * 264 + pg * 64 + 8 * pq4), a1 = *(const LAS bf16x8*)(plb + pl15 * 264 + pg * 64 + 32 + 8 * pq4);
#pragma unroll
        for (int dd = 0; dd < 2; ++dd) {
          f32x4 acc = (f32x4){0.f, 0.f, 0.f, 0.f};
          acc = __builtin_amdgcn_mfma_f32_16x16x32_bf16(a0, pf[dd][0], acc, 0, 0, 0);
          acc = __builtin_amdgcn_mfma_f32_16x16x32_bf16(a1, pf[dd][1], acc, 0, 0, 0);
          const int dcol = ((pwv >> 2) * 2 + dd) * 16 + pl15;
#pragma unroll
          for (int i = 0; i < 4; ++i) Y[(size_t)(tok0 + 4 * pq4 + i) * DM + 768 + pg * 64 + dcol] = (bf16_t)(pkbf(acc[i] * psc[dd], 0.f) & 0xffffu);
        }
      }
      __syncthreads();
    }
  }
  {
    const _Float16* YH = (const _Float16*)(p->ws + WS_YH); const _Float16* BON = (const _Float16*)(p->ws + WS_BON);
    const float* mu = p->in[8] + l * APROJ; const float* g_up = p->in[13] + (size_t)l * 64 * AW; const float* gn_g = p->in[17] + l * AW; const float* gn_b = p->in[18] + l * AW;
    LAS unsigned short* sgb = (LAS unsigned short*)(lds + 8192);
    const int wv = tid >> 6, l15 = lane & 15, q4 = lane >> 4, hd = wv < 6 ? wv : 5;
    bf16x8 gf[4][2];
#pragma unroll
    for (int dt = 0; dt < 4; ++dt)
#pragma unroll
      for (int s2 = 0; s2 < 2; ++s2) {
        const float* gp = g_up + (size_t)(32 * s2 + 8 * q4) * AW + hd * 64 + dt * 16 + l15;
        u32x4 w; w.x = pkbf(gp[0], gp[AW]); w.y = pkbf(gp[2 * AW], gp[3 * AW]); w.z = pkbf(gp[4 * AW], gp[5 * AW]); w.w = pkbf(gp[6 * AW], gp[7 * AW]);
        gf[dt][s2] = __builtin_bit_cast(bf16x8, w);
      }
    float gng[4], gnb[4];
#pragma unroll
    for (int dt = 0; dt < 4; ++dt) { gng[dt] = gn_g[hd * 64 + dt * 16 + l15]; gnb[dt] = gn_b[hd * 64 + dt * 16 + l15]; }
    bf16_t gcur[2], gprv[2]; _Float16 yv[16], bv[16], yn[16], bn[16];
    const float mul0 = mu[1216 + (tid & 63)];
    auto fin_fetch = [&](int tile, bf16_t (&gc)[2], bf16_t (&gp)[2], _Float16 (&y)[16], _Float16 (&bb)[16]) {
      const int tok0 = tile * 16;
#pragma unroll
      for (int q = 0; q < 2; ++q) { const int e = tid + 512 * q, i = e >> 6, j = e & 63, tok = tok0 + i, t = tok & (TSEQ - 1);
        gc[q] = P[(size_t)tok * PW + 1216 + j]; gp[q] = t > 0 ? P[(size_t)(tok - 1) * PW + 1216 + j] : (bf16_t)0; }
#pragma unroll
      for (int i = 0; i < 4; ++i)
#pragma unroll
        for (int dt = 0; dt < 4; ++dt) { const size_t o = (size_t)(tok0 + 4 * q4 + i) * AW + hd * 64 + dt * 16 + l15; y[i * 4 + dt] = YH[o]; bb[i * 4 + dt] = BON[o]; }
    };
    fin_fetch(bid, gcur, gprv, yv, bv);
    for (int r3 = 0; r3 < (REPK == 63 ? 2 : 1); ++r3)
    for (int tile = bid; tile < 1024; tile += G) {
      const int tok0 = tile * 16;
#pragma unroll
      for (int q = 0; q < 2; ++q) { const int e = tid + 512 * q; const float gc = bf2f(gcur[q]), gp = bf2f(gprv[q]); sgb[(e >> 6) * 72 + (e & 63)] = (unsigned short)(pkbf(sigmoidf_(gc + mul0 * (gp - gc)), 0.f) & 0xffffu); }
      __syncthreads();
      { const int nt = (tile + G < 1024) ? tile + G : tile; fin_fetch(nt, gcur, gprv, yn, bn); }
      __builtin_amdgcn_sched_barrier(0);
      if (wv < 6) {
        const bf16x8 a0 = *(const LAS bf16x8*)(sgb + l15 * 72 + 8 * q4), a1 = *(const LAS bf16x8*)(sgb + l15 * 72 + 32 + 8 * q4);
        f32x4 gacc[4];
#pragma unroll
        for (int dt = 0; dt < 4; ++dt) {
          gacc[dt] = (f32x4){0.f, 0.f, 0.f, 0.f};
          gacc[dt] = __builtin_amdgcn_mfma_f32_16x16x32_bf16(a0, gf[dt][0], gacc[dt], 0, 0, 0);
          gacc[dt] = __builtin_amdgcn_mfma_f32_16x16x32_bf16(a1, gf[dt][1], gacc[dt], 0, 0, 0);
        }
#pragma unroll
        for (int i = 0; i < 4; ++i) {
          const size_t tok = tok0 + 4 * q4 + i;
          float y[4], sum = 0.f;
#pragma unroll
          for (int dt = 0; dt < 4; ++dt) { y[dt] = (float)yv[i * 4 + dt]; sum += y[dt]; }
          const float mean = allreduce16(sum) * (1.0f / 64.0f);
          float var = 0.f;
#pragma unroll
          for (int dt = 0; dt < 4; ++dt) { y[dt] -= mean; var += y[dt] * y[dt]; }
          const float rs = __builtin_amdgcn_rsqf(allreduce16(var) * (1.0f / 64.0f) + 64e-5f);
#pragma unroll
          for (int dt = 0; dt < 4; ++dt) {
            const float o = (y[dt] * rs * gng[dt] + gnb[dt] + (float)bv[i * 4 + dt]) * gacc[dt][i];
            Y[tok * DM + hd * 64 + dt * 16 + l15] = (bf16_t)(pkbf(o, 0.f) & 0xffffu);
          }
        }
      }
#pragma unroll
      for (int i = 0; i < 16; ++i) { yv[i] = yn[i]; bv[i] = bn[i]; }
      __syncthreads();
    }
  }
}

constexpr int XK_PITCH = 528, XV_PITCH = 80, XK_BYTES = 32 * XK_PITCH, XV_BYTES = 256 * XV_PITCH, XBUF = XK_BYTES + XV_BYTES;
DI void phase_xattn(KP p, LAS unsigned char* lds, int tid, int bid, int G) {
  const bf16_t* QC = (const bf16_t*)(p->ws + WS_U); bf16_t* OC = (bf16_t*)(p->ws + WS_U + (size_t)MTOK * DM * 2);
  const bf16_t* KNC = (const bf16_t*)(p->ws + WS_KNC); const bf16_t* VTC = (const bf16_t*)(p->ws + WS_VTC);
  const int lane = tid & 63, wave = tid >> 6, c = lane & 31, hh = lane >> 5, qb = wave >> 1, dh = wave & 1;
  const int lk = tid >> 4, lp = tid & 15, ld = tid >> 1, lh = tid & 1;
  for (int u = bid; u < 512; u += G) {
    const int b = u >> 6, h = (u >> 4) & 3, qg = u & 15;
    const size_t qrow = (size_t)(b * TSEQ + qg * 128 + qb * 32 + c);
    const bf16_t* qp = QC + qrow * DM + h * 256 + 8 * hh;
    bf16x8 qreg[16]; float sq = 0.f;
#pragma unroll
    for (int s = 0; s < 16; ++s) { qreg[s] = *(const bf16x8*)(qp + 16 * s); sq += sumsq8(qreg[s]); }
    sq += __shfl_xor(sq, 32);
    const float sc = __builtin_amdgcn_rsqf(sq * (1.0f / 256.0f) + RMS_EPS) * 0.0625f * LOG2E;
    const bf16_t* ksrc = KNC + (size_t)(b * 256 + lk) * 1024 + h * 256 + lp * 16;
    const bf16_t* vsrc = VTC + ((size_t)(b * 4 + h) * 256 + ld) * 256 + lh * 16;
    u32x4 kr0 = *(const u32x4*)ksrc, kr1 = *(const u32x4*)(ksrc + 8), vr0 = *(const u32x4*)vsrc, vr1 = *(const u32x4*)(vsrc + 8);
    __syncthreads();
    { LAS unsigned char* kb = lds + lk * XK_PITCH + lp * 32; *(LAS u32x4*)kb = kr0; *(LAS u32x4*)(kb + 16) = kr1;
      LAS unsigned char* vb = lds + XK_BYTES + ld * XV_PITCH + lh * 32; *(LAS u32x4*)vb = vr0; *(LAS u32x4*)(vb + 16) = vr1; }
    __syncthreads();
    f32x16 o[4];
#pragma unroll
    for (int dt = 0; dt < 4; ++dt)
#pragma unroll
      for (int i = 0; i < 16; ++i) o[dt][i] = 0.f;
    float m = -1e30f, lsum = 0.f;
#pragma unroll 1
    for (int kt = 0; kt < 8; ++kt) {
      if (kt + 1 < 8) { const bf16_t* ks = ksrc + (size_t)(kt + 1) * 32 * 1024; const bf16_t* vs = vsrc + (kt + 1) * 32;
        kr0 = *(const u32x4*)ks; kr1 = *(const u32x4*)(ks + 8); vr0 = *(const u32x4*)vs; vr1 = *(const u32x4*)(vs + 8); }
      const LAS unsigned char* kbase = lds + (kt & 1) * XBUF + c * XK_PITCH + hh * 16;
      const LAS unsigned char* vbase = lds + (kt & 1) * XBUF + XK_BYTES + (dh * 128 + c) * XV_PITCH + hh * 8;
      f32x16 st;
#pragma unroll
      for (int i = 0; i < 16; ++i) st[i] = 0.f;
#pragma unroll
      for (int s = 0; s < 16; ++s) st = MFMA32(*(const LAS bf16x8*)(kbase + s * 32), qreg[s], st);
      float tmax = -1e30f;
#pragma unroll
      for (int i = 0; i < 16; ++i) { st[i] *= sc; tmax = fmaxf(tmax, st[i]); }
      tmax = fmaxf(tmax, __shfl_xor(tmax, 32));
      const float mn = fmaxf(m, tmax), alpha = __builtin_amdgcn_exp2f(m - mn); m = mn;
      float psum = 0.f;
#pragma unroll
      for (int i = 0; i < 16; ++i) { st[i] = __builtin_amdgcn_exp2f(st[i] - mn); psum += st[i]; }
      lsum = lsum * alpha + psum;
      const bf16x8 p0 = pack8(st, 0), p1 = pack8(st, 1);
      const bool resc = __builtin_amdgcn_ballot_w64(alpha != 1.0f) != 0ull;
#pragma unroll
      for (int dt = 0; dt < 4; ++dt) {
        if (resc) {
#pragma unroll
          for (int i = 0; i < 16; ++i) o[dt][i] *= alpha; }
        const LAS unsigned char* vp = vbase + dt * 32 * XV_PITCH;
        const u32x2 a0 = *(const LAS u32x2*)vp, a1 = *(const LAS u32x2*)(vp + 16), a2 = *(const LAS u32x2*)(vp + 32), a3 = *(const LAS u32x2*)(vp + 48);
        u32x4 w0; w0.x = a0.x; w0.y = a0.y; w0.z = a1.x; w0.w = a1.y;
        u32x4 w1; w1.x = a2.x; w1.y = a2.y; w1.z = a3.x; w1.w = a3.y;
        o[dt] = MFMA32(__builtin_bit_cast(bf16x8, w0), p0, o[dt]);
        o[dt] = MFMA32(__builtin_bit_cast(bf16x8, w1), p1, o[dt]);
      }
      if (kt + 1 < 8) {
        LAS unsigned char* nb = lds + ((kt + 1) & 1) * XBUF;
        LAS unsigned char* kb = nb + lk * XK_PITCH + lp * 32; *(LAS u32x4*)kb = kr0; *(LAS u32x4*)(kb + 16) = kr1;
        LAS unsigned char* vb = nb + XK_BYTES + ld * XV_PITCH + lh * 32; *(LAS u32x4*)vb = vr0; *(LAS u32x4*)(vb + 16) = vr1;
      }
      __syncthreads();
    }
    lsum += __shfl_xor(lsum, 32);
    const float linv = __builtin_amdgcn_rcpf(lsum);
    bf16_t* op = OC + qrow * DM + h * 256 + dh * 128 + 4 * hh;
#pragma unroll
    for (int dt = 0; dt < 4; ++dt)
#pragma unroll
      for (int g = 0; g < 4; ++g) {
        u32x2 w; w.x = pkbf(o[dt][4 * g] * linv, o[dt][4 * g + 1] * linv); w.y = pkbf(o[dt][4 * g + 2] * linv, o[dt][4 * g + 3] * linv);
        *(u32x2*)(op + dt * 32 + 8 * g) = w;
      }
  }
}

#define XB_TMO      128
#define XB_XCNT(j)  (256  + 64 * (j))
#define XB_XSUB(j)  (1280 + 64 * (j))
#define XB_XGEN(j)  (2304 + 64 * (j))
#define XB_TOP      3328
#define XB_TOPGEN   3392
#define XB_XSUB(j)  (1280 + 64 * (j))
#define XB_XGEN(j)  (2304 + 64 * (j))
#define XB_TOP      3328
#define XB_TOPGEN   3392
#define XCD_BAR_WORDS 3456
#define XB_SPIN_CAP (1u << 18)

DI unsigned xb_ld(unsigned* p)              { return __hip_atomic_load(p, __ATOMIC_RELAXED, __HIP_MEMORY_SCOPE_AGENT); }
DI unsigned xb_add(unsigned* p, unsigned v) { return __hip_atomic_fetch_add(p, v, __ATOMIC_RELAXED, __HIP_MEMORY_SCOPE_AGENT); }
DI unsigned xb_xcc_id() { return (unsigned)__builtin_amdgcn_s_getreg((3 << 11) | 20) & 0xFu; }
#define XB_SPIN(cond, bar) do { unsigned _sp = 0; while (cond) { __builtin_amdgcn_s_sleep(1); \
    if ((++_sp & 255u) == 0u) { if (xb_ld(&(bar)[XB_TMO])) break; if (_sp > XB_SPIN_CAP) { atomicAdd(&(bar)[XB_TMO], 1u); break; } } } } while (0)

struct XcdBarrier {
    unsigned* bar; unsigned x;
    volatile LAS unsigned* st;
};

DI XcdBarrier xcd_barrier_post(unsigned* bar, volatile LAS unsigned* st) {
    XcdBarrier b; b.bar = bar; b.x = xb_xcc_id(); b.st = st;
    if (threadIdx.x == 0) (void)xb_add(&bar[XB_XCNT(b.x)], 1u);
    return b;
}
DI void xcd_barrier_complete(unsigned* bar, unsigned x, unsigned& nloc, unsigned& nx) {
    const unsigned G = gridDim.x * gridDim.y * gridDim.z;
    unsigned sum, cnt, mine, sp = 0u;
    for (;;) {
        sum = 0u; cnt = 0u; mine = 0u;
#pragma unroll
        for (unsigned j = 0; j < 16; ++j) { const unsigned c = xb_ld(&bar[XB_XCNT(j)]); sum += c; cnt += (c > 0u) ? 1u : 0u; mine = (j == x) ? c : mine; }
        if (sum == G) break;
        __builtin_amdgcn_s_sleep(1);
        if ((++sp & 255u) == 0u) { if (xb_ld(&bar[XB_TMO])) break; if (sp > XB_SPIN_CAP) { atomicAdd(&bar[XB_TMO], 1u); break; } }
    }
    nloc = mine > 0u ? mine : 1u; nx = cnt > 0u ? cnt : 1u;
}

DI void xcd_barrier(const XcdBarrier& b) {
    asm volatile("s_waitcnt vmcnt(0)" ::: "memory");
    __syncthreads();
    if (threadIdx.x == 0) {
        unsigned* bar = b.bar;
        __builtin_amdgcn_s_waitcnt(0);
        unsigned nloc = b.st[0], nx = b.st[1];
        if (nloc == 0u) { xcd_barrier_complete(bar, b.x, nloc, nx); b.st[0] = nloc; b.st[1] = nx; }
        const unsigned old = xb_add(&bar[XB_XSUB(b.x)], 1u);
        const unsigned gen = old / nloc;
        if (old + 1u == (gen + 1u) * nloc) {
            __builtin_amdgcn_fence(__ATOMIC_RELEASE, "agent");
            asm volatile("s_waitcnt vmcnt(0)" ::: "memory");
            const unsigned og = xb_add(&bar[XB_TOP], 1u);
            const unsigned tg = og / nx;
            if (og + 1u == (tg + 1u) * nx) xb_add(&bar[XB_TOPGEN], 1u);
            else XB_SPIN(xb_ld(&bar[XB_TOPGEN]) == tg, bar);
            __builtin_amdgcn_fence(__ATOMIC_ACQUIRE, "agent");
            xb_add(&bar[XB_XGEN(b.x)], 1u);
            asm volatile("s_waitcnt vmcnt(0)" ::: "memory");
        } else {
            XB_SPIN(xb_ld(&bar[XB_XGEN(b.x)]) == gen, bar);
            __builtin_amdgcn_fence(__ATOMIC_ACQUIRE, "agent");
            asm volatile("s_waitcnt vmcnt(0)" ::: "memory");
        }
    }
    __syncthreads();
}

constexpr int LDS_BYTES = 131072 + 64;
constexpr int N_PHASES = 30;
constexpr int SCAN_BLOCKS = 192;
#ifndef HIDE_CONV
#define HIDE_CONV 1
#endif
constexpr int CONV_A = 16 * 176 + 44 * 32 + 16 * 88 + 16 * 64, CONV_ALL = 2 * 16 * 176 + 2 * 44 * 32 + 16 * 88 + 16 * 64 + 3 * 16 * 32;
#ifndef PH_MASK
#define PH_MASK 0xff
#endif
#define EN(k) (((PH_MASK) >> (k)) & 1)
#ifndef REPK
#define REPK -1
#endif
__global__ void __launch_bounds__(512, 2) mk_fwd(Params p) {
  extern __shared__ __attribute__((aligned(16))) unsigned char lds_raw[];
  LAS unsigned char* lds = (LAS unsigned char*)lds_raw;
  cg::grid_group grid = cg::this_grid();
  const int ph_lo = p.ph_lo, ph_hi = p.ph_hi;
  volatile LAS unsigned* bst = (volatile LAS unsigned*)(lds + 131072);
  if (threadIdx.x < 2) bst[threadIdx.x] = 0u;
  __syncthreads();
  XcdBarrier xbar = xcd_barrier_post((unsigned*)(p.ws + WS_BAR), bst);
  int rep = 0; unsigned nbar = 0;
#pragma unroll 1
  for (int ph = ph_lo; ph < ph_hi;) {
    KP kp = (KP)__builtin_amdgcn_kernarg_segment_ptr();
    asm volatile("" : "+s"(kp));
    int tid = threadIdx.x; asm volatile("" : "+v"(tid));
    int bid = blockIdx.x; asm volatile("" : "+s"(bid));
    int G = gridDim.x; asm volatile("" : "+s"(G));
    const int lane = tid & 63, wave = __builtin_amdgcn_readfirstlane(tid >> 6);
    const int gw = bid * 8 + wave, NGW = G * 8;
    unsigned char* ws = kp->ws; unsigned char* W = ws + WS_W;
    bf16_t* XB = (bf16_t*)(ws + WS_XB); float* SS = (float*)(ws + WS_SS); bf16_t* U = (bf16_t*)(ws + WS_U);
    const int l = ph >= 15 ? 1 : 0, s = ph - 15 * l;
    if (s == 6 || s == 7) { ++ph; continue; }
    if (EN(0) && s == 0) {
      phase_conv(kp, l, lds, gw, NGW, wave, lane, 0, CONV_ALL);
      if (l == 0) phase_init(kp, gw, NGW, lane, 0);
    } else if (EN(1) && (s == 1 || s == 13)) {
      pg8::Gemm g{XB, (const bf16_t*)(W + (s == 1 ? W_WI1 : W_WI2)), MTOK, 5632, 1024};
      pg8::StaticOrder S; S.init(MTOK, 5632, G, bid);
      EpiSwiGLU E{U, SS};
      pg8::gemm_phase<EpiSwiGLU, pg8::StaticOrder, true, true>(lds, g, S, E, tid);
    } else if (EN(2) && (s == 2 || s == 14 || s == 9 || s == 12)) {
      const bf16_t* A = (s == 9) ? (const bf16_t*)(ws + WS_Y) : (s == 12) ? (const bf16_t*)(ws + WS_U + (size_t)MTOK * DM * 2) : (const bf16_t*)U;
      const size_t wo = (s == 2) ? W_WO1 : (s == 14) ? W_WO2 : (s == 9) ? W_WOUT : W_WOX;
      pg8::Gemm g{A, (const bf16_t*)(W + wo), MTOK, 1024, (s == 2 || s == 14) ? 2816 : 1024};
      pg8::StaticOrder S; S.init(MTOK, 1024, G, bid);
      EpiResid E{kp->in[0], kp->out, XB, SS, (s == 2 || s == 14) ? 0.5f : 1.0f, ph == 2, ph == N_PHASES - 1};
      pg8::gemm_phase<EpiResid, pg8::StaticOrder, true, true>(lds, g, S, E, tid);
    } else if (EN(3) && (s == 3 || s == 10)) {
      pg8::Gemm g{XB, (const bf16_t*)(W + (s == 3 ? W_WIN : W_WQ)), MTOK, 1024, 1024};
      WinOrder S; S.init(s == 3 ? 2816 : 1024, G, bid, s == 3);
      EpiScaleBf16 E{U, s == 3 ? PW : DM, SS, (bf16_t*)(ws + WS_KVC), 2048, (const float*)(ws + WS_RSM)};
      pg8::gemm_phase<EpiScaleBf16, WinOrder, true, true>(lds, g, S, E, tid);
    } else if (EN(4) && (s == 4 || s == 6)) {
      phase_prep_rwkv(kp, l, 0, lds, tid, bid, G);
      if (s == 4 && rep == 0) { phase_attn_prep<0>(kp, l, lds, gw, NGW, wave, lane); if (G <= SCAN_BLOCKS) phase_attn_prep<1>(kp, l, lds, gw, NGW, wave, lane); }
    } else if (EN(5) && (s == 5 || s == 7)) {
      if (G > SCAN_BLOCKS && bid >= SCAN_BLOCKS) {
        phase_chunk(kp, l, lds, tid, (bid - SCAN_BLOCKS) * 8 + wave, (G - SCAN_BLOCKS) * 8, 0, 1536);
        __syncthreads();
        phase_attn_prep<1>(kp, l, lds, (bid - SCAN_BLOCKS) * 8 + wave, (G - SCAN_BLOCKS) * 8, wave, lane);
      }
      phase_scan(kp, 0, lds, tid, bid);
    } else if (EN(6) && s == 8) {
      if (G <= SCAN_BLOCKS) { phase_chunk(kp, l, lds, tid, gw, NGW, 0, 1536); __syncthreads(); }
      phase_attn(kp, l, lds, tid, gw, NGW, bid, G);
    } else if (EN(7) && s == 11) {
      phase_xattn(kp, lds, tid, bid, G);
    }
    if (REPK >= 0 && REPK < 9) {
      const int kind = (s == 0) ? 0 : (s == 1 || s == 13) ? 1 : (s == 3 || s == 10) ? 3 : (s == 4 || s == 6) ? 4 : (s == 5 || s == 7) ? 5 : (s == 8) ? 6 : (s == 11) ? 7 : 2;
      if (kind == REPK && rep == 0) { rep = 1; if (REPK == 2) xcd_barrier(xbar); __syncthreads(); continue; }
      rep = 0;
    }
    if (ph + 1 < ph_hi) {
      if (ph_hi > 1000) grid.sync();
      xcd_barrier(xbar); if (REPK == 9) xcd_barrier(xbar);
    }
    ++ph;
  }
}

extern "C" void kernel_launch(void* const* d_in, const int* in_sizes, int n_in, void* d_out, int out_size, void* d_ws, size_t ws_size, hipStream_t stream) {
  static int grid = 0;
  if (grid == 0) {
    if (n_in != 37 || out_size != MTOK * DM || ws_size < WS_END) { fprintf(stderr, "kernel_launch: unexpected shapes / workspace (n_in %d out %d ws %zu need %zu)\n", n_in, out_size, ws_size, (size_t)WS_END); grid = -1; return; }
    int dev = 0, cus = 0, per_cu = 0;
    (void)hipGetDevice(&dev);
    (void)hipDeviceGetAttribute(&cus, hipDeviceAttributeMultiprocessorCount, dev);
    (void)hipFuncSetAttribute((const void*)mk_fwd, hipFuncAttributeMaxDynamicSharedMemorySize, LDS_BYTES);
    (void)hipOccupancyMaxActiveBlocksPerMultiprocessor(&per_cu, (const void*)mk_fwd, 512, LDS_BYTES);
    if (per_cu < 1) { fprintf(stderr, "kernel_launch: occupancy query says %d blocks/CU\n", per_cu); per_cu = 1; }
    if (cus < SCAN_BLOCKS) { fprintf(stderr, "kernel_launch: this kernel needs >= %d CUs (found %d)\n", SCAN_BLOCKS, cus); grid = -1; return; }
    grid = cus;
    (void)hipGetLastError();
  }
  if (grid < 0) return;
  Params p{};
  for (int i = 0; i < 37; ++i) p.in[i] = (const float*)d_in[i];
  p.out = (float*)d_out; p.ws = (unsigned char*)d_ws;
  (void)hipMemsetAsync((unsigned char*)d_ws + WS_BAR, 0, 16384, stream);
#if MK_LAUNCHES == 1
  p.ph_lo = 0; p.ph_hi = N_PHASES;
  void* args[] = {&p};
  hipError_t e = hipLaunchCooperativeKernel((const void*)mk_fwd, dim3(grid), dim3(512), args, LDS_BYTES, stream);
  if (e != hipSuccess) fprintf(stderr, "cooperative launch failed: %s (grid %d)\n", hipGetErrorString(e), grid);
#else
  for (int ph = 0; ph < N_PHASES; ++ph) { p.ph_lo = ph; p.ph_hi = ph + 1; hipLaunchKernelGGL(mk_fwd, dim3(grid), dim3(512), LDS_BYTES, stream, p); }
#endif
}
```
